# Optimizing an MI355X kernel written in HIP

```python
import jax, jax.numpy as jnp
from jax import lax
import numpy as np

D_MODEL = 1024
BATCH = 8
SEQ = 4096
DEPTH = 1

ATT_HEAD_DIM = 128
ATT_GROUPS = ((128, 1), (512, 4), (2048, 16))
ATT_N_GROUPS = 3
ATT_KV_HEADS = 4
ATT_Q_HEADS = ATT_N_GROUPS * ATT_KV_HEADS
ATT_Q_WIDTH = ATT_Q_HEADS * ATT_HEAD_DIM
ATT_KV_WIDTH = ATT_KV_HEADS * ATT_HEAD_DIM
ATT_BLOCK = 128
ROPE_THETA = 10000.0
M_HEADS = 4
M_HEAD_DIM = 256
M_WIDTH = M_HEADS * M_HEAD_DIM
M_CONV = 4
M_CHUNK = 128
IN_WIDTH = ATT_Q_WIDTH + 3 * ATT_KV_WIDTH + 3 * M_WIDTH + 2 * D_MODEL
LN_EPS = 1e-5

kernel_name = 'hybrid_dilated_attn_mlstm_gated_merge'


def _layer_norm(x):
    xf = x.astype(jnp.float32)
    mu = jnp.mean(xf, axis=-1, keepdims=True)
    var = jnp.mean(jnp.square(xf - mu), axis=-1, keepdims=True)
    return (xf - mu) * lax.rsqrt(var + LN_EPS)


def _rope(x, pos):
    half = x.shape[-1] // 2
    inv = jnp.power(ROPE_THETA, -jnp.arange(half, dtype=jnp.float32) / half)
    ang = pos.astype(jnp.float32)[..., None] * inv
    cos = jnp.cos(ang)[:, :, None, :]
    sin = jnp.sin(ang)[:, :, None, :]
    x1, x2 = x[..., :half], x[..., half:]
    return jnp.concatenate([x1 * cos - x2 * sin, x2 * cos + x1 * sin], axis=-1)


def _dilated_window_attention(q, k, v, dilation, n_steps):
    B, S, H, E = q.shape
    span = dilation * ATT_BLOCK
    s_pad = -(-S // span) * span
    pad = ((0, 0), (0, s_pad - S), (0, 0), (0, 0))
    q, k, v = jnp.pad(q, pad), jnp.pad(k, pad), jnp.pad(v, pad)
    nb = s_pad // span
    shape = (B, nb, ATT_BLOCK, dilation, H, E)
    qb, kb, vb = q.reshape(shape), k.reshape(shape), v.reshape(shape)

    def with_prev(a):
        prev = jnp.pad(a[:, :-1], ((0, 0), (1, 0), (0, 0), (0, 0), (0, 0), (0, 0)))
        return jnp.concatenate([prev, a], axis=2)

    kk, vv = with_prev(kb), with_prev(vb)
    s = jnp.einsum('bnidhe,bnjdhe->bndhij', qb, kk)
    i = jnp.arange(ATT_BLOCK)[:, None]
    j = jnp.arange(2 * ATT_BLOCK)[None, :]
    dist = ATT_BLOCK + i - j
    first = (jnp.arange(nb) == 0)[:, None, None]
    valid = (dist >= 0) & (dist <= n_steps) & ~(first & (j < ATT_BLOCK))
    s = jnp.where(valid[None, :, None, None], s, -jnp.inf)
    m = jnp.max(s, axis=-1, keepdims=True)
    p = jnp.exp(s - m)
    den = jnp.sum(p, axis=-1)
    o = jnp.einsum('bndhij,bnjdhe->bnidhe', p, vv) / jnp.transpose(den, (0, 1, 4, 2, 3))[..., None]
    lse = jnp.transpose(m[..., 0] + jnp.log(den), (0, 1, 4, 2, 3))
    o = o.reshape(B, s_pad, H, E)[:, :S]
    lse = lse.reshape(B, s_pad, H)[:, :S]
    return o, lse


def _causal_conv(x, w, b):
    C = x.shape[-1]
    y = lax.conv_general_dilated(
        x.astype(jnp.float32), w.astype(jnp.float32)[:, None, :], window_strides=(1,),
        padding=[(M_CONV - 1, 0)], dimension_numbers=('NWC', 'WIO', 'NWC'),
        feature_group_count=C)
    return y + b.astype(jnp.float32)


def _mlstm_chunkwise(q, k, v, log_i, log_f):
    B, S, H, E = q.shape
    nc = S // M_CHUNK

    def chunks(a):
        return a.reshape(B, nc, M_CHUNK, H, E).transpose(0, 3, 1, 2, 4)

    def gchunks(a):
        return a.reshape(B, nc, M_CHUNK, H).transpose(0, 3, 1, 2)

    q, k, v = chunks(q), chunks(k), chunks(v)
    li, lf = gchunks(log_i), gchunks(log_f)
    b = jnp.cumsum(lf, axis=-1)
    b_last = b[..., -1]
    w_src = b_last[..., None] - b + li
    a = jnp.max(w_src, axis=-1)
    e_src = jnp.exp(w_src - a[..., None])
    c_loc = jnp.einsum('bhcs,bhcsd,bhcse->bhcde', e_src, v, k)
    n_loc = jnp.einsum('bhcs,bhcse->bhce', e_src, k)

    def step(carry, inp):
        c_st, n_st, m_st = carry
        c_l, n_l, a_c, bl, q_c = inp
        num_inter = jnp.einsum('bhde,bhte->bhtd', c_st, q_c)
        den_inter = jnp.einsum('bhe,bhte->bht', n_st, q_c)
        m_new = jnp.maximum(bl + m_st, a_c)
        decay = jnp.exp(bl + m_st - m_new)
        gain = jnp.exp(a_c - m_new)
        c_st = decay[..., None, None] * c_st + gain[..., None, None] * c_l
        n_st = decay[..., None] * n_st + gain[..., None] * n_l
        return (c_st, n_st, m_new), (num_inter, den_inter, m_st)

    init = (jnp.zeros((B, H, E, E), jnp.float32), jnp.zeros((B, H, E), jnp.float32),
            jnp.zeros((B, H), jnp.float32))
    xs = (jnp.moveaxis(c_loc, 2, 0), jnp.moveaxis(n_loc, 2, 0), jnp.moveaxis(a, 2, 0),
          jnp.moveaxis(b_last, 2, 0), jnp.moveaxis(q, 2, 0))
    _, (num_inter, den_inter, m_prev) = lax.scan(step, init, xs)
    num_inter = jnp.moveaxis(num_inter, 0, 2)
    den_inter = jnp.moveaxis(den_inter, 0, 2)
    m_prev = jnp.moveaxis(m_prev, 0, 2)

    causal = jnp.tril(jnp.ones((M_CHUNK, M_CHUNK), dtype=bool))
    dmat = jnp.where(causal, b[..., :, None] - b[..., None, :] + li[..., None, :], -jnp.inf)
    g = b + m_prev[..., None]
    m_t = jnp.maximum(g, jnp.max(dmat, axis=-1))
    smat = jnp.einsum('bhcte,bhcse->bhcts', q, k) * jnp.exp(dmat - m_t[..., None])
    w_inter = jnp.exp(g - m_t)
    num = w_inter[..., None] * num_inter + jnp.einsum('bhcts,bhcsd->bhctd', smat, v)
    den = w_inter * den_inter + jnp.sum(smat, axis=-1)
    h = num / jnp.maximum(jnp.abs(den), jnp.exp(-m_t))[..., None]
    return h.transpose(0, 2, 3, 1, 4).reshape(B, S, H, E)


def _hybrid_layer(x, c, positions, w_ada, b_ada, w_in, conv_w, conv_b, w_qm, w_km, w_vm,
                  w_if, b_if, mh_norm_w, skip_m, w_pa, w_pm, w_out, ln_g, ln_b):
    B, S, _ = x.shape
    dt = x.dtype
    f32 = jnp.float32
    alpha = (2.0 * DEPTH) ** 0.25
    ada = (jax.nn.silu(c) @ w_ada + b_ada).astype(f32)
    shift, scale, gate = jnp.split(ada, 3, axis=-1)
    h = (_layer_norm(x) * (1.0 + scale[:, None]) + shift[:, None]).astype(dt)

    proj = h @ w_in
    sizes = [ATT_Q_WIDTH, ATT_KV_WIDTH, ATT_KV_WIDTH, ATT_KV_WIDTH, M_WIDTH, M_WIDTH, M_WIDTH, D_MODEL]
    offs = [int(o) for o in np.cumsum(sizes)]
    q_a, k_a, v_a, z_a, x_m, z_m, o_m, g_a, g_m = jnp.split(proj, offs, axis=-1)

    q = _rope(q_a.reshape(B, S, ATT_Q_HEADS, ATT_HEAD_DIM).astype(f32), positions) * (ATT_HEAD_DIM ** -0.5)
    q = q.reshape(B, S, ATT_N_GROUPS, ATT_KV_HEADS, ATT_HEAD_DIM)
    k = _rope(k_a.reshape(B, S, ATT_KV_HEADS, ATT_HEAD_DIM).astype(f32), positions)
    v = v_a.reshape(B, S, ATT_KV_HEADS, ATT_HEAD_DIM).astype(f32)
    outs, lses = [], []
    for g_idx, (window, dil) in enumerate(ATT_GROUPS):
        o_g, l_g = _dilated_window_attention(q[:, :, g_idx], k, v, dil, window // dil)
        outs.append(o_g)
        lses.append(l_g)
    wgt = jax.nn.softmax(jnp.stack(lses, axis=0), axis=0)
    o_att = jnp.sum(wgt[..., None] * jnp.stack(outs, axis=0), axis=0).reshape(B, S, ATT_KV_WIDTH)
    y_att = (o_att * jax.nn.silu(z_a.astype(f32))).astype(dt) @ w_pa

    xc = jax.nn.silu(_causal_conv(x_m, conv_w, conv_b))
    xch = xc.reshape(B, S, M_HEADS, M_HEAD_DIM)
    qm = jnp.einsum('bshd,hde->bshe', xch, w_qm.astype(f32))
    km = jnp.einsum('bshd,hde->bshe', xch, w_km.astype(f32)) * (M_HEAD_DIM ** -0.5)
    vm = jnp.einsum('bshd,hde->bshe', x_m.reshape(B, S, M_HEADS, M_HEAD_DIM).astype(f32), w_vm.astype(f32))
    qkv = jnp.concatenate([qm.reshape(B, S, M_WIDTH), km.reshape(B, S, M_WIDTH), vm.reshape(B, S, M_WIDTH)], axis=-1)
    gates = qkv @ w_if.astype(f32) + b_if.astype(f32)
    log_i = gates[..., :M_HEADS]
    log_f = jax.nn.log_sigmoid(gates[..., M_HEADS:])
    hm = _mlstm_chunkwise(qm, km, vm, log_i, log_f)
    hm = jax.nn.sigmoid(o_m.astype(f32)).reshape(B, S, M_HEADS, M_HEAD_DIM) * hm
    hm = _layer_norm(hm) * mh_norm_w.astype(f32).reshape(M_HEADS, M_HEAD_DIM)
    hm = hm.reshape(B, S, M_WIDTH) + skip_m.astype(f32) * xc
    y_m = (hm * jax.nn.silu(z_m.astype(f32))).astype(dt) @ w_pm

    merged = jax.nn.sigmoid(g_a) * y_att + jax.nn.sigmoid(g_m) * y_m
    out = (merged @ w_out).astype(f32)
    res = alpha * x.astype(f32) + gate[:, None] * out
    return (_layer_norm(res) * ln_g.astype(f32) + ln_b.astype(f32)).astype(dt)


def setup_inputs(seed: int = 0) -> dict:
    key = jax.random.key(seed)
    ks = jax.random.split(key, 24)
    f32 = jnp.float32
    beta = (8.0 * DEPTH) ** -0.25

    def nrm(k, shape, scale):
        return jax.random.normal(k, shape, f32) * scale

    x = jax.random.normal(ks[0], (BATCH, SEQ, D_MODEL), f32)
    c = jax.random.normal(ks[1], (BATCH, D_MODEL), f32)
    offset = jax.random.randint(ks[2], (BATCH, 1), 0, 1024, dtype=jnp.int32)
    positions = (jnp.arange(SEQ, dtype=jnp.int32)[None, :] + offset).astype(jnp.int32)
    w_ada = nrm(ks[3], (DEPTH, D_MODEL, 3 * D_MODEL), D_MODEL ** -0.5)
    b_ada = nrm(ks[4], (DEPTH, 3 * D_MODEL), 0.02)
    w_in = nrm(ks[5], (DEPTH, D_MODEL, IN_WIDTH), D_MODEL ** -0.5)
    conv_w = nrm(ks[6], (DEPTH, M_CONV, M_WIDTH), M_CONV ** -0.5)
    conv_b = nrm(ks[7], (DEPTH, M_WIDTH), 0.02)
    w_qm = nrm(ks[8], (DEPTH, M_HEADS, M_HEAD_DIM, M_HEAD_DIM), M_HEAD_DIM ** -0.5)
    w_km = nrm(ks[9], (DEPTH, M_HEADS, M_HEAD_DIM, M_HEAD_DIM), M_HEAD_DIM ** -0.5)
    w_vm = nrm(ks[10], (DEPTH, M_HEADS, M_HEAD_DIM, M_HEAD_DIM), M_HEAD_DIM ** -0.5)
    w_if = nrm(ks[11], (DEPTH, 3 * M_WIDTH, 2 * M_HEADS), (3 * M_WIDTH) ** -0.5)
    b_i = nrm(ks[12], (DEPTH, M_HEADS), 0.1)
    b_f = 3.0 + nrm(ks[13], (DEPTH, M_HEADS), 0.5)
    b_if = jnp.concatenate([b_i, b_f], axis=-1)
    mh_norm_w = 1.0 + nrm(ks[14], (DEPTH, M_WIDTH), 0.02)
    skip_m = 1.0 + nrm(ks[15], (DEPTH, M_WIDTH), 0.02)
    w_pa = nrm(ks[16], (DEPTH, ATT_KV_WIDTH, D_MODEL), beta * ATT_KV_WIDTH ** -0.5)
    w_pm = nrm(ks[17], (DEPTH, M_WIDTH, D_MODEL), beta * M_WIDTH ** -0.5)
    w_out = nrm(ks[18], (DEPTH, D_MODEL, D_MODEL), beta * D_MODEL ** -0.5)
    ln_g = 1.0 + nrm(ks[19], (DEPTH, D_MODEL), 0.02)
    ln_b = nrm(ks[20], (DEPTH, D_MODEL), 0.02)
    return {'x': x, 'c': c, 'positions': positions, 'w_ada': w_ada, 'b_ada': b_ada,
            'w_in': w_in, 'conv_w': conv_w, 'conv_b': conv_b, 'w_qm': w_qm, 'w_km': w_km,
            'w_vm': w_vm, 'w_if': w_if, 'b_if': b_if, 'mh_norm_w': mh_norm_w, 'skip_m': skip_m,
            'w_pa': w_pa, 'w_pm': w_pm, 'w_out': w_out, 'ln_g': ln_g, 'ln_b': ln_b}


def reference(x, c, positions, w_ada, b_ada, w_in, conv_w, conv_b, w_qm, w_km, w_vm,
              w_if, b_if, mh_norm_w, skip_m, w_pa, w_pm, w_out, ln_g, ln_b):
    for l in range(DEPTH):
        x = _hybrid_layer(x, c, positions, w_ada[l], b_ada[l], w_in[l], conv_w[l], conv_b[l],
                          w_qm[l], w_km[l], w_vm[l], w_if[l], b_if[l], mh_norm_w[l], skip_m[l],
                          w_pa[l], w_pm[l], w_out[l], ln_g[l], ln_b[l])
    return x
```

```cpp
#include <hip/hip_runtime.h>
#include <cstdio>
#include <cstdint>
#include <cstring>
#include <cmath>
constexpr int BATCH = 8, SEQ = 4096, DM = 1024, TT = BATCH * SEQ, NHALF = 2, TH = TT / NHALF, INW = 8192;
constexpr int MH = 4, MHD = 256, MCHUNK = 128;
constexpr float LN_EPS = 1e-5f;
constexpr float ATT_SCALE = 0.08838834764831845f;
constexpr int NWAVES = 8;
constexpr size_t MiB = 1u << 20;
constexpr size_t WS_CTL = 0, CTL_ZERO_BYTES = 1 * MiB;
constexpr size_t WS_ADA = 1 * MiB;
constexpr size_t WS_GW = 1 * MiB + 128 * 1024;
constexpr size_t WS_GATES = 2 * MiB;
constexpr size_t WS_LSE = 3 * MiB;
constexpr size_t WS_WIN = 4 * MiB, WS_WPA = 20 * MiB, WS_WPM = 21 * MiB, WS_WOUT = 23 * MiB, WS_WQKV = 25 * MiB;
constexpr size_t WS_ROPE = 27 * MiB;
constexpr size_t WS_QA = 44 * MiB, WS_KA = 92 * MiB, WS_VA = 108 * MiB, WS_ZA = 124 * MiB, WS_XM = 140 * MiB, WS_ZM = 172 * MiB, WS_OM = 204 * MiB, WS_GA = 236 * MiB, WS_GM = 268 * MiB;
constexpr size_t WS_XC = 300 * MiB, WS_QM = 332 * MiB, WS_KM = 364 * MiB, WS_VM = 396 * MiB, WS_OG = 428 * MiB, WS_END = 476 * MiB;
constexpr size_t WS_Y = WS_XM;
constexpr size_t WS_HMG = WS_QA;
constexpr size_t WS_ATG = WS_KA;
constexpr size_t WS_MRG = WS_QM;
constexpr int CW_TMO = 0, CW_CODE = 1;
constexpr int CW_BAR = 4096;
constexpr int CW_QUEUE = 16384;
constexpr int RING_OFF = 0, RING_BYTES = 131072;
constexpr int LDSCTL_OFF = RING_BYTES, MISC_OFF = LDSCTL_OFF + 320;
constexpr int LDS_BYTES = 147456;
static_assert(MISC_OFF + 128 <= LDS_BYTES, "LDS map");

namespace pg8 {
#define PG8_LAS __attribute__((address_space(3)))
typedef unsigned short bf16_t;
typedef short bf16x8 __attribute__((ext_vector_type(8)));
typedef float f32x4 __attribute__((ext_vector_type(4)));
typedef float f32x2 __attribute__((ext_vector_type(2)));
typedef unsigned u32x4 __attribute__((ext_vector_type(4)));
typedef unsigned u32x2 __attribute__((ext_vector_type(2)));
constexpr int BM = 256, BK = 64, HALF = 128, HTB = HALF * BK * 2  , STAGE_BYTES = 8 * HTB, NXCD = 8, WGM = 8;

__host__ __device__ __forceinline__ int lds_byte(int r, int c) { const int st = (r >> 4) * 2 + (c >> 5), rr = r & 15, cc = c & 31, ob = rr * 64 + cc * 2; return st * 1024 + (ob ^ (((ob >> 9) & 1) << 5)); }
__host__ __device__ __forceinline__ void stage_rc(int b, int& R, int& C) { const int st = b / 1024, sb = b % 1024, swz = sb ^ (((sb >> 9) & 1) << 5); R = (st >> 1) * 16 + swz / 64; C = (st & 1) * 32 + (swz % 64) / 2; }
__host__ __device__ __forceinline__ int perm32(int rho) { const int n = rho >> 4, i = rho & 15; return 8 * (i >> 2) + 4 * n + (i & 3); }

struct Unit { int pm, pn; const char* a; const char* b; };
struct Gemm { int lda, ldb, K; };

struct OrderBase {
    int nM, nN, nwg, G, c;
    __device__ void init(int nM_, int nN_, int G_, int c_) { nM = nM_; nN = nN_; nwg = nM * nN; G = G_; c = c_; }
    __device__ bool tile(int i, int& pm, int& pn) const {
        const long L = (long)i * G + c; if (L >= nwg) return false;
        int wgid = (int)L; { const int q = nwg / NXCD, r = nwg % NXCD, xcd = wgid % NXCD, off = wgid / NXCD; wgid = (xcd < r ? xcd * (q + 1) : r * (q + 1) + (xcd - r) * q) + off; }
        const int nig = WGM * nN, gid = wgid / nig, fm = gid * WGM, gsz = (nM - fm) < WGM ? (nM - fm) : WGM;
        pm = fm + ((wgid % nig) % gsz); pn = (wgid % nig) / gsz; return true;
    }
};
struct PlainOrder : OrderBase {
    const char* A; const char* Bt; size_t astep, bstep;
    __device__ void set(const void* A_, const void* Bt_, int lda, int ldb) { A = (const char*)A_; Bt = (const char*)Bt_; astep = (size_t)256 * lda * 2; bstep = (size_t)256 * ldb * 2; }
    __device__ bool next(int i, Unit& u) const { if (!tile(i, u.pm, u.pn)) return false; u.a = A + (size_t)u.pm * astep; u.b = Bt + (size_t)u.pn * bstep; return true; }
    __device__ __forceinline__ void a_ready(const Unit&) const {}
    __device__ __forceinline__ void done(const Unit&) const {}
};
struct QkvOrder : OrderBase {
    const char* ws;
    __device__ bool next(int i, Unit& u) const { if (!tile(i, u.pm, u.pn)) return false; const int which = u.pn >> 2, head = u.pn & 3;
        u.a = ws + (which < 2 ? WS_XC : WS_XM) + ((size_t)u.pm * 256 * 1024 + head * 256) * 2; u.b = ws + WS_WQKV + (size_t)u.pn * 256 * 256 * 2; return true; }
    __device__ __forceinline__ void a_ready(const Unit&) const {}
    __device__ __forceinline__ void done(const Unit&) const {}
};

__device__ __forceinline__ unsigned cvt_pk_bf16(float lo, float hi) { unsigned r; asm volatile("v_cvt_pk_bf16_f32 %0, %1, %2" : "=v"(r) : "v"(lo), "v"(hi)); return r; }
__device__ __forceinline__ float bf_lo(unsigned w) { return __uint_as_float(w << 16); }
__device__ __forceinline__ float bf_hi(unsigned w) { return __uint_as_float(w & 0xffff0000u); }
__device__ __forceinline__ float sigmoidf_fast(float v) { return __builtin_amdgcn_rcpf(1.0f + __builtin_amdgcn_exp2f(-1.4426950408889634f * v)); }


struct EpiProj {
    static constexpr bool PERM = true, AFTER_DRAIN = false;
    unsigned char* ws;
    const float* rope;
    __device__ __forceinline__ void operator()(const f32x4 (&acc)[2][2][4][2], const Unit& u, int wr, int wc, int fr, int fq) const {
        const int row0 = u.pm * BM + wr * 64 + fr; const int pn = u.pn;
        if (pn < 8) {
            const int hl = wc >> 1, e0 = 32 * (wc & 1) + 8 * fq;
            bf16_t* base; int ld;
            if (pn < 6) { base = (bf16_t*)(ws + WS_QA) + (pn * 2 + hl) * 128 + e0; ld = 1536; } else { base = (bf16_t*)(ws + WS_KA) + ((pn - 6) * 2 + hl) * 128 + e0; ld = 512; }
#pragma unroll
            for (int ai = 0; ai < 2; ++ai)
#pragma unroll
                for (int m = 0; m < 4; ++m) { const int r = row0 + ai * HALF + m * 16;
                    const f32x4* tb = (const f32x4*)(rope + (size_t)r * 128 + e0 * 2);
                    const f32x4 t0 = tb[0], t1 = tb[1], t2 = tb[2], t3 = tb[3];
                    const f32x4 x1a = acc[ai][0][m][0], x1b = acc[ai][0][m][1], x2a = acc[ai][1][m][0], x2b = acc[ai][1][m][1];
                    float o1[8], o2[8];
                    o1[0] = x1a[0] * t0[0] - x2a[0] * t0[1]; o2[0] = x2a[0] * t0[0] + x1a[0] * t0[1];
                    o1[1] = x1a[1] * t0[2] - x2a[1] * t0[3]; o2[1] = x2a[1] * t0[2] + x1a[1] * t0[3];
                    o1[2] = x1a[2] * t1[0] - x2a[2] * t1[1]; o2[2] = x2a[2] * t1[0] + x1a[2] * t1[1];
                    o1[3] = x1a[3] * t1[2] - x2a[3] * t1[3]; o2[3] = x2a[3] * t1[2] + x1a[3] * t1[3];
                    o1[4] = x1b[0] * t2[0] - x2b[0] * t2[1]; o2[4] = x2b[0] * t2[0] + x1b[0] * t2[1];
                    o1[5] = x1b[1] * t2[2] - x2b[1] * t2[3]; o2[5] = x2b[1] * t2[2] + x1b[1] * t2[3];
                    o1[6] = x1b[2] * t3[0] - x2b[2] * t3[1]; o2[6] = x2b[2] * t3[0] + x1b[2] * t3[1];
                    o1[7] = x1b[3] * t3[2] - x2b[3] * t3[3]; o2[7] = x2b[3] * t3[2] + x1b[3] * t3[3];
                    u32x4 w1, w2;
                    w1.x = cvt_pk_bf16(o1[0], o1[1]); w1.y = cvt_pk_bf16(o1[2], o1[3]); w1.z = cvt_pk_bf16(o1[4], o1[5]); w1.w = cvt_pk_bf16(o1[6], o1[7]);
                    w2.x = cvt_pk_bf16(o2[0], o2[1]); w2.y = cvt_pk_bf16(o2[2], o2[3]); w2.z = cvt_pk_bf16(o2[4], o2[5]); w2.w = cvt_pk_bf16(o2[6], o2[7]);
                    bf16_t* rp = base + (size_t)r * ld;
                    *(u32x4*)rp = w1; *(u32x4*)(rp + 64) = w2; }
        } else {
            bf16_t* base; int ld, act, ct;
            if (pn < 10)      { base = (bf16_t*)(ws + WS_VA); ld = 512;  act = 0; ct = pn - 8; }
            else if (pn < 12) { base = (bf16_t*)(ws + WS_ZA); ld = 512;  act = 1; ct = pn - 10; }
            else if (pn < 16) { base = (bf16_t*)(ws + WS_XM); ld = 1024; act = 0; ct = pn - 12; }
            else if (pn < 20) { base = (bf16_t*)(ws + WS_ZM); ld = 1024; act = 1; ct = pn - 16; }
            else if (pn < 24) { base = (bf16_t*)(ws + WS_OM); ld = 1024; act = 2; ct = pn - 20; }
            else if (pn < 28) { base = (bf16_t*)(ws + WS_GA); ld = 1024; act = 2; ct = pn - 24; }
            else              { base = (bf16_t*)(ws + WS_GM); ld = 1024; act = 2; ct = pn - 28; }
            const int col0 = ct * BM + wc * 32 + 8 * fq;
#pragma unroll
            for (int ai = 0; ai < 2; ++ai)
#pragma unroll
                for (int m = 0; m < 4; ++m) { bf16_t* rowp = base + (size_t)(row0 + ai * HALF + m * 16) * ld + col0;
#pragma unroll
                    for (int bj = 0; bj < 2; ++bj) { f32x4 v0 = acc[ai][bj][m][0], v1 = acc[ai][bj][m][1];
                        if (act != 0) {
#pragma unroll
                            for (int j = 0; j < 4; ++j) { const float s0 = sigmoidf_fast(v0[j]), s1 = sigmoidf_fast(v1[j]); v0[j] = (act == 1) ? v0[j] * s0 : s0; v1[j] = (act == 1) ? v1[j] * s1 : s1; } }
                        u32x4 w; w.x = cvt_pk_bf16(v0[0], v0[1]); w.y = cvt_pk_bf16(v0[2], v0[3]); w.z = cvt_pk_bf16(v1[0], v1[1]); w.w = cvt_pk_bf16(v1[2], v1[3]);
                        *(u32x4*)(rowp + bj * HALF) = w; } }
        }
    }
};
struct EpiQkv {
    static constexpr bool PERM = true, AFTER_DRAIN = false;
    unsigned char* ws;
    __device__ __forceinline__ void operator()(const f32x4 (&acc)[2][2][4][2], const Unit& u, int wr, int wc, int fr, int fq) const {
        const int which = u.pn >> 2, head = u.pn & 3; bf16_t* base = (bf16_t*)(ws + (which == 0 ? WS_QM : (which == 1 ? WS_KM : WS_VM))); const float sc = which == 1 ? 0.0625f : 1.0f;
        const int row0 = u.pm * BM + wr * 64 + fr, col0 = head * 256 + wc * 32 + 8 * fq;
#pragma unroll
        for (int ai = 0; ai < 2; ++ai)
#pragma unroll
            for (int m = 0; m < 4; ++m) { bf16_t* rowp = base + (size_t)(row0 + ai * HALF + m * 16) * 1024 + col0;
#pragma unroll
                for (int bj = 0; bj < 2; ++bj) { const f32x4 v0 = acc[ai][bj][m][0] * sc, v1 = acc[ai][bj][m][1] * sc;
                    u32x4 w; w.x = cvt_pk_bf16(v0[0], v0[1]); w.y = cvt_pk_bf16(v0[2], v0[3]); w.z = cvt_pk_bf16(v1[0], v1[1]); w.w = cvt_pk_bf16(v1[2], v1[3]);
                    *(u32x4*)(rowp + bj * HALF) = w; } }
    }
};
template <int MODE> struct EpiGate {
    static constexpr bool PERM = true, AFTER_DRAIN = false;
    const bf16_t* G; bf16_t* P;
    __device__ __forceinline__ void operator()(const f32x4 (&acc)[2][2][4][2], const Unit& u, int wr, int wc, int fr, int fq) const {
        const int row0 = u.pm * BM + wr * 64 + fr, col0 = u.pn * BM + wc * 32 + 8 * fq;
#pragma unroll
        for (int ai = 0; ai < 2; ++ai)
#pragma unroll
            for (int m = 0; m < 4; ++m) { const size_t off = (size_t)(row0 + ai * HALF + m * 16) * 1024 + col0;
#pragma unroll
                for (int bj = 0; bj < 2; ++bj) { const u32x4 g = *(const u32x4*)(G + off + bj * HALF); const f32x4 a0 = acc[ai][bj][m][0], a1 = acc[ai][bj][m][1];
                    float o[8];
                    o[0] = bf_lo(g.x) * a0[0]; o[1] = bf_hi(g.x) * a0[1]; o[2] = bf_lo(g.y) * a0[2]; o[3] = bf_hi(g.y) * a0[3];
                    o[4] = bf_lo(g.z) * a1[0]; o[5] = bf_hi(g.z) * a1[1]; o[6] = bf_lo(g.w) * a1[2]; o[7] = bf_hi(g.w) * a1[3];
                    if (MODE == 1) { const u32x4 p = *(const u32x4*)(P + off + bj * HALF);
                        o[0] += bf_lo(p.x); o[1] += bf_hi(p.x); o[2] += bf_lo(p.y); o[3] += bf_hi(p.y); o[4] += bf_lo(p.z); o[5] += bf_hi(p.z); o[6] += bf_lo(p.w); o[7] += bf_hi(p.w); }
                    u32x4 w; w.x = cvt_pk_bf16(o[0], o[1]); w.y = cvt_pk_bf16(o[2], o[3]); w.z = cvt_pk_bf16(o[4], o[5]); w.w = cvt_pk_bf16(o[6], o[7]);
                    *(u32x4*)(P + off + bj * HALF) = w; } }
    }
};
struct EpiRes {
    static constexpr bool PERM = false, AFTER_DRAIN = false;
    const float* x; float* out; const float* gate; int grow0; float alpha;
    __device__ __forceinline__ void operator()(const f32x4 (&acc)[2][2][4][2], const Unit& u, int wr, int wc, int fr, int fq) const {
        const int row0 = u.pm * BM + wr * 64 + fr, col0 = u.pn * BM + wc * 32 + 4 * fq;
        const int b = (grow0 + u.pm * BM) >> 12;
        f32x4 gv[2][2];
#pragma unroll
        for (int bj = 0; bj < 2; ++bj)
#pragma unroll
            for (int n = 0; n < 2; ++n) gv[bj][n] = *(const f32x4*)(gate + (size_t)b * 3072 + col0 + bj * HALF + n * 16);
#pragma unroll
        for (int ai = 0; ai < 2; ++ai)
#pragma unroll
            for (int m = 0; m < 4; ++m) { const size_t off = (size_t)(row0 + ai * HALF + m * 16) * 1024 + col0;
#pragma unroll
                for (int bj = 0; bj < 2; ++bj)
#pragma unroll
                    for (int n = 0; n < 2; ++n) { const f32x4 xv = *(const f32x4*)(x + off + bj * HALF + n * 16); *(f32x4*)(out + off + bj * HALF + n * 16) = xv * alpha + gv[bj][n] * acc[ai][bj][m][n]; } }
    }
};

template <class Epi, class Sched, bool ALIGN_EPI = false, bool SP2 = false>
__device__ __forceinline__ void gemm_phase(PG8_LAS unsigned char* lds, const Gemm g, const Sched& S, const Epi& E, const int tid) {
    const int wid = __builtin_amdgcn_readfirstlane(tid >> 6), lane = tid & 63, wr = wid >> 2, wc = wid & 3, fr = lane & 15, fq = lane >> 4;
    const int K = g.K, nt = K / BK;
    unsigned voffA[2], voffB[2];
#pragma unroll
    for (int i = 0; i < 2; ++i) { int R, C; stage_rc(tid * 16 + i * 8192, R, C); const int Rb = Epi::PERM ? ((R & ~31) + perm32(R & 31)) : R;
        voffA[i] = (unsigned)(R * g.lda + C) * 2u; voffB[i] = (unsigned)(Rb * g.ldb + C) * 2u; }
    const size_t kstep = (size_t)(BK * 2);
    const size_t hstepA = (size_t)HALF * g.lda * 2, hstepB = (size_t)HALF * g.ldb * 2;
    const unsigned ldsw = (unsigned)wid * 1024u;
    const int aoff = lds_byte(wr * 64 + fr, fq * 8), boff = lds_byte(wc * 32 + fr, fq * 8);
#define PG8_SA(b, h) (((b) * 2 + (h)) * HTB)
#define PG8_SB(b, h) ((4 + (b) * 2 + (h)) * HTB)
#define PG8_STAGE(bufoff, gbase, voff) do { _Pragma("unroll") for (int _i = 0; _i < 2; ++_i) \
        __builtin_amdgcn_global_load_lds((const unsigned*)((const char*)(gbase) + (voff)[_i]), (PG8_LAS unsigned*)(lds + (bufoff) + ldsw + _i * 8192), 16, 0, 0); } while (0)
#define PG8_LDA(dst, b, h) do { _Pragma("unroll") for (int m = 0; m < 4; ++m) _Pragma("unroll") for (int k = 0; k < 2; ++k) dst[m][k] = *(const PG8_LAS bf16x8*)(lds + PG8_SA(b, h) + aoff + m * 2048 + k * 1024); } while (0)
#define PG8_LDB(dst, b, h) do { _Pragma("unroll") for (int n = 0; n < 2; ++n) _Pragma("unroll") for (int k = 0; k < 2; ++k) dst[n][k] = *(const PG8_LAS bf16x8*)(lds + PG8_SB(b, h) + boff + n * 2048 + k * 1024); } while (0)
#define PG8_MMA(ai, bj, At, Bt) do { __builtin_amdgcn_s_setprio(1); _Pragma("unroll") for (int m = 0; m < 4; ++m) _Pragma("unroll") for (int n = 0; n < 2; ++n) _Pragma("unroll") for (int k = 0; k < 2; ++k) \
        acc[ai][bj][m][n] = __builtin_amdgcn_mfma_f32_16x16x32_bf16(Bt[n][k], At[m][k], acc[ai][bj][m][n], 0, 0, 0); __builtin_amdgcn_s_setprio(0); } while (0)
#define PG8_WAIT_V(n) asm volatile("s_waitcnt vmcnt(" #n ")" ::: "memory")
#define PG8_WAIT_L(n) asm volatile("s_waitcnt lgkmcnt(" #n ")" ::: "memory")
#define PG8_BAR __builtin_amdgcn_s_barrier()
#define PG8_SCHED __builtin_amdgcn_sched_barrier(0)
    Unit cur, nxt; int ui = 0;
    if (!S.next(0, cur)) return;
    f32x4 acc[2][2][4][2];
#pragma unroll
    for (int a = 0; a < 2; ++a)
#pragma unroll
        for (int b = 0; b < 2; ++b)
#pragma unroll
            for (int m = 0; m < 4; ++m)
#pragma unroll
                for (int n = 0; n < 2; ++n) acc[a][b][m][n] = (f32x4){0.f, 0.f, 0.f, 0.f};
    bf16x8 At[4][2], B0[2][2], B1[2][2];
    const char* cA = cur.a; const char* cB = cur.b;
    S.a_ready(cur);
    if constexpr (SP2) {
        PG8_STAGE(PG8_SB(0, 0), cB, voffB); PG8_STAGE(PG8_SB(0, 1), cB + hstepB, voffB); PG8_STAGE(PG8_SA(0, 0), cA, voffA); PG8_STAGE(PG8_SA(0, 1), cA + hstepA, voffA);
        if (wr == 1) PG8_BAR;
        PG8_WAIT_V(2); PG8_BAR;
        PG8_STAGE(PG8_SB(1, 0), cB + kstep, voffB); PG8_STAGE(PG8_SA(1, 0), cA + kstep, voffA); PG8_STAGE(PG8_SB(1, 1), cB + hstepB + kstep, voffB);
        PG8_WAIT_V(6); PG8_BAR;
    } else {
        PG8_STAGE(PG8_SB(0, 0), cB, voffB); PG8_STAGE(PG8_SA(0, 0), cA, voffA); PG8_STAGE(PG8_SB(0, 1), cB + hstepB, voffB); PG8_STAGE(PG8_SA(0, 1), cA + hstepA, voffA);
        if (wr == 1) PG8_BAR;
        PG8_WAIT_V(4); PG8_BAR;
        PG8_STAGE(PG8_SB(1, 0), cB + kstep, voffB); PG8_STAGE(PG8_SA(1, 0), cA + kstep, voffA); PG8_STAGE(PG8_SB(1, 1), cB + hstepB + kstep, voffB);
        PG8_WAIT_V(6); PG8_BAR;
    }
    for (;;) {
        const bool has_next = S.next(ui + 1, nxt);
        const char* nA = has_next ? nxt.a : cA; const char* nB = has_next ? nxt.b : cB;
        for (int t = 0; t < nt; t += 2) {
            const bool last = (t == nt - 2);
            const char* a1 = cA + (size_t)(t + 1) * kstep;
            const char* a2 = last ? nA : cA + (size_t)(t + 2) * kstep; const char* b2 = last ? nB : cB + (size_t)(t + 2) * kstep;
            const char* a3 = a2 + kstep; const char* b3 = b2 + kstep;
            if (last && has_next) S.a_ready(nxt);
            if constexpr (SP2) {
            PG8_LDB(B0, 0, 0); PG8_LDB(B1, 0, 1); PG8_SCHED; PG8_LDA(At, 0, 0); PG8_STAGE(PG8_SA(1, 1), a1 + hstepA, voffA);
            PG8_WAIT_V(8); PG8_WAIT_L(0); PG8_BAR; PG8_MMA(0, 0, At, B0); PG8_MMA(0, 1, At, B1); PG8_BAR; PG8_SCHED;
            PG8_LDA(At, 0, 1); PG8_STAGE(PG8_SB(0, 0), b2, voffB); PG8_STAGE(PG8_SB(0, 1), b2 + hstepB, voffB); PG8_STAGE(PG8_SA(0, 0), a2, voffA);
            PG8_WAIT_V(8); PG8_WAIT_L(0); PG8_BAR; PG8_MMA(1, 0, At, B0); PG8_MMA(1, 1, At, B1); PG8_BAR; PG8_SCHED;
            PG8_LDB(B0, 1, 0); PG8_LDB(B1, 1, 1); PG8_SCHED; PG8_LDA(At, 1, 0); PG8_STAGE(PG8_SA(0, 1), a2 + hstepA, voffA);
            PG8_WAIT_V(8); PG8_WAIT_L(0); PG8_BAR; PG8_MMA(0, 0, At, B0); PG8_MMA(0, 1, At, B1); PG8_BAR; PG8_SCHED;
            PG8_LDA(At, 1, 1); PG8_STAGE(PG8_SB(1, 0), b3, voffB); PG8_STAGE(PG8_SB(1, 1), b3 + hstepB, voffB); PG8_STAGE(PG8_SA(1, 0), a3, voffA);
            PG8_WAIT_V(8); PG8_WAIT_L(0); PG8_BAR; PG8_MMA(1, 0, At, B0); PG8_MMA(1, 1, At, B1); PG8_BAR; PG8_SCHED;
            } else {
            PG8_LDB(B0, 0, 0); PG8_SCHED; PG8_LDA(At, 0, 0); PG8_STAGE(PG8_SA(1, 1), a1 + hstepA, voffA);
            PG8_WAIT_L(8); PG8_BAR; PG8_WAIT_L(0); PG8_MMA(0, 0, At, B0); PG8_BAR; PG8_SCHED;
            PG8_LDB(B1, 0, 1); PG8_STAGE(PG8_SB(0, 0), b2, voffB);
            PG8_BAR; PG8_WAIT_L(0); PG8_MMA(0, 1, At, B1); PG8_BAR;
            PG8_LDA(At, 0, 1); PG8_STAGE(PG8_SA(0, 0), a2, voffA);
            PG8_BAR; PG8_WAIT_L(0); PG8_MMA(1, 0, At, B0); PG8_BAR; PG8_SCHED;
            PG8_STAGE(PG8_SB(0, 1), b2 + hstepB, voffB);
            PG8_WAIT_V(6); PG8_BAR; PG8_MMA(1, 1, At, B1); PG8_BAR;
            PG8_LDB(B0, 1, 0); PG8_SCHED; PG8_LDA(At, 1, 0); PG8_STAGE(PG8_SA(0, 1), a2 + hstepA, voffA);
            PG8_WAIT_L(8); PG8_BAR; PG8_WAIT_L(0); PG8_MMA(0, 0, At, B0); PG8_BAR; PG8_SCHED;
            PG8_LDB(B1, 1, 1); PG8_STAGE(PG8_SB(1, 0), b3, voffB);
            PG8_BAR; PG8_WAIT_L(0); PG8_MMA(0, 1, At, B1); PG8_BAR;
            PG8_LDA(At, 1, 1); PG8_STAGE(PG8_SA(1, 0), a3, voffA);
            PG8_BAR; PG8_WAIT_L(0); PG8_MMA(1, 0, At, B0); PG8_BAR; PG8_SCHED;
            PG8_STAGE(PG8_SB(1, 1), b3 + hstepB, voffB);
            PG8_WAIT_V(6); PG8_BAR; PG8_MMA(1, 1, At, B1); PG8_BAR;
            }
        }
        if constexpr (ALIGN_EPI) { if (wr == 0) PG8_BAR; }
        if constexpr (!Epi::AFTER_DRAIN) { E(acc, cur, wr, wc, fr, fq); S.done(cur); }
        if (!has_next) break;
#pragma unroll
        for (int a = 0; a < 2; ++a)
#pragma unroll
            for (int b = 0; b < 2; ++b)
#pragma unroll
                for (int m = 0; m < 4; ++m)
#pragma unroll
                    for (int n = 0; n < 2; ++n) acc[a][b][m][n] = (f32x4){0.f, 0.f, 0.f, 0.f};
        cur = nxt; cA = nA; cB = nB; ++ui;
        if constexpr (ALIGN_EPI) { if (wr == 1) PG8_BAR; }
    }
    PG8_WAIT_V(0);
    if constexpr (!ALIGN_EPI) { if (wr == 0) PG8_BAR; }
    PG8_BAR;
    if constexpr (Epi::AFTER_DRAIN) { E.fused(acc, cur, wr, wc, fr, fq, lds, wid, lane); S.done(cur); }
#undef PG8_SA
#undef PG8_SB
#undef PG8_STAGE
#undef PG8_LDA
#undef PG8_LDB
#undef PG8_MMA
#undef PG8_WAIT_V
#undef PG8_WAIT_L
#undef PG8_BAR
#undef PG8_SCHED
}
}
#define GAS __attribute__((address_space(1)))
#define LAS __attribute__((address_space(3)))
typedef unsigned short bf16;
typedef unsigned v4u __attribute__((ext_vector_type(4)));
typedef unsigned v2u __attribute__((ext_vector_type(2)));
typedef float f32x4 __attribute__((ext_vector_type(4)));
typedef float f32x2 __attribute__((ext_vector_type(2)));
typedef GAS unsigned gu32;
#define RLX_AGENT __ATOMIC_RELAXED, __HIP_MEMORY_SCOPE_AGENT
#define LDS_WAIT() asm volatile("s_waitcnt lgkmcnt(0)" ::: "memory")
#define VM_WAIT() asm volatile("s_waitcnt vmcnt(0)" ::: "memory")
__device__ __forceinline__ unsigned f2bf(float f) { unsigned u = __builtin_bit_cast(unsigned, f); return (u + 0x7fffu + ((u >> 16) & 1u)) >> 16; }
__device__ __forceinline__ unsigned pk2(float lo, float hi) { return f2bf(lo) | (f2bf(hi) << 16); }
__device__ __forceinline__ float bflo(unsigned w) { return __uint_as_float(w << 16); }
__device__ __forceinline__ float bfhi(unsigned w) { return __uint_as_float(w & 0xffff0000u); }
__device__ __forceinline__ float bf2f(bf16 b) { return __uint_as_float(((unsigned)b) << 16); }

#define XB_TMO      128
#define XB_XCNT(j)  (256  + 64 * (j))
#define XB_XSUB(j)  (1280 + 64 * (j))
#define XB_XGEN(j)  (2304 + 64 * (j))
#define XB_TOP      3328
#define XB_TOPGEN   3392
#define XCD_BAR_WORDS 3456
#define XB_SPIN_CAP (1u << 22)

__device__ __forceinline__ unsigned xb_ld(unsigned* p)              { return __hip_atomic_load(p, __ATOMIC_RELAXED, __HIP_MEMORY_SCOPE_AGENT); }
__device__ __forceinline__ unsigned xb_add(unsigned* p, unsigned v) { return __hip_atomic_fetch_add(p, v, __ATOMIC_RELAXED, __HIP_MEMORY_SCOPE_AGENT); }
__device__ __forceinline__ unsigned xb_xcc_id() { return (unsigned)__builtin_amdgcn_s_getreg((3 << 11) | 20) & 0xFu; }
#define XB_SPIN(cond, bar) do { unsigned _sp = 0; while (cond) { __builtin_amdgcn_s_sleep(1); \
    if ((++_sp & 255u) == 0u) { if (xb_ld(&(bar)[XB_TMO])) break; if (_sp > XB_SPIN_CAP) { atomicAdd(&(bar)[XB_TMO], 1u); break; } } } } while (0)

struct XcdBarrier { unsigned* bar; unsigned x; volatile LAS unsigned* st; };
__device__ __forceinline__ XcdBarrier xcd_barrier_post(unsigned* bar, volatile LAS unsigned* st) {
    XcdBarrier b; b.bar = bar; b.x = xb_xcc_id(); b.st = st;
    if (threadIdx.x == 0) (void)xb_add(&bar[XB_XCNT(b.x)], 1u);
    return b;
}
__device__ __forceinline__ void xcd_barrier_complete(unsigned* bar, unsigned x, unsigned& nloc, unsigned& nx) {
    const unsigned G = gridDim.x * gridDim.y * gridDim.z;
    unsigned sum, cnt, mine, sp = 0u;
    for (;;) {
        sum = 0u; cnt = 0u; mine = 0u;
#pragma unroll
        for (unsigned j = 0; j < 16; ++j) { const unsigned c = xb_ld(&bar[XB_XCNT(j)]); sum += c; cnt += (c > 0u) ? 1u : 0u; mine = (j == x) ? c : mine; }
        if (sum == G) break;
        __builtin_amdgcn_s_sleep(1);
        if ((++sp & 255u) == 0u) { if (xb_ld(&bar[XB_TMO])) break; if (sp > XB_SPIN_CAP) { atomicAdd(&bar[XB_TMO], 1u); break; } }
    }
    nloc = mine > 0u ? mine : 1u; nx = cnt > 0u ? cnt : 1u;
}
__device__ __forceinline__ void xcd_barrier(const XcdBarrier& b) {
    asm volatile("s_waitcnt vmcnt(0)" ::: "memory");
    __syncthreads();
    if (threadIdx.x == 0) {
        unsigned* bar = b.bar;
        __builtin_amdgcn_s_waitcnt(0);
        unsigned nloc = b.st[0], nx = b.st[1];
        if (nloc == 0u) { xcd_barrier_complete(bar, b.x, nloc, nx); b.st[0] = nloc; b.st[1] = nx; }
        const unsigned old = xb_add(&bar[XB_XSUB(b.x)], 1u);
        const unsigned gen = old / nloc;
        if (old + 1u == (gen + 1u) * nloc) {
            __builtin_amdgcn_fence(__ATOMIC_RELEASE, "agent");
            asm volatile("s_waitcnt vmcnt(0)" ::: "memory");
            const unsigned og = xb_add(&bar[XB_TOP], 1u);
            const unsigned tg = og / nx;
            if (og + 1u == (tg + 1u) * nx) xb_add(&bar[XB_TOPGEN], 1u);
            else XB_SPIN(xb_ld(&bar[XB_TOPGEN]) == tg, bar);
            __builtin_amdgcn_fence(__ATOMIC_ACQUIRE, "agent");
            xb_add(&bar[XB_XGEN(b.x)], 1u);
            asm volatile("s_waitcnt vmcnt(0)" ::: "memory");
        } else {
            XB_SPIN(xb_ld(&bar[XB_XGEN(b.x)]) == gen, bar);
            __builtin_amdgcn_fence(__ATOMIC_ACQUIRE, "agent");
            asm volatile("s_waitcnt vmcnt(0)" ::: "memory");
        }
    }
    __syncthreads();
}

struct Frame {
    LAS unsigned char* lds;
    volatile LAS unsigned* MISC;
    gu32* ctl;
    int tid, lane, wave;
    int vcu, G;
    unsigned char* ws;
    float* out;
};
__device__ __forceinline__ float wave_sum(float v) {
#pragma unroll
    for (int o = 1; o < 64; o <<= 1) v += __shfl_xor(v, o);
    return v;
}
__device__ __forceinline__ int win_dest_row(int n) {
    if (n >= 2048) return n;
    const int n256 = n & 255, base = n - n256, hl = n256 >> 7, e = n256 & 127, bj = e >> 6;
    return base + 128 * bj + hl * 64 + (e & 63);
}
template <bool PERMUTE>
__device__ __forceinline__ void p0_transpose_item(const float* W, int K, int N, bf16* WT, int row_off, LAS float* scr, int item, int lane) {
    const int nblk = N / 32, kb = item / nblk, nb = item % nblk, k0 = 64 * kb, n0 = 32 * nb;
#pragma unroll 8
    for (int i = 0; i < 32; ++i) { const int kk = 2 * i + (lane >> 5); scr[kk * 33 + (lane & 31)] = W[(size_t)(k0 + kk) * N + n0 + (lane & 31)]; }
    LDS_WAIT(); asm volatile("" ::: "memory");
    const int c = lane & 7;
#pragma unroll
    for (int j = 0; j < 4; ++j) { const int n = (lane >> 3) + 8 * j; const LAS float* s = scr + (8 * c) * 33 + n;
        v4u o; o.x = pk2(s[0 * 33], s[1 * 33]); o.y = pk2(s[2 * 33], s[3 * 33]); o.z = pk2(s[4 * 33], s[5 * 33]); o.w = pk2(s[6 * 33], s[7 * 33]);
        const int dr = row_off + (PERMUTE ? win_dest_row(n0 + n) : (n0 + n));
        *(GAS v4u*)(WT + (size_t)dr * K + k0 + 8 * c) = o; }
    LDS_WAIT(); asm volatile("" ::: "memory");
}
struct RopeTab { double inv2pi[64]; };
__device__ __forceinline__ void p0a_prologue(Frame& F, const float* I_c, const float* I_w_ada, const float* I_b_ada, const float* I_w_in, const float* I_w_qm, const float* I_w_km, const float* I_w_vm, const float* I_w_if,
                                             const float* I_w_pa, const float* I_w_pm, const float* I_w_out, const int* I_pos, const double* inv2pi, int bid) {
    const int gtid = F.vcu * 512 + F.tid, NT = F.G * 512;
    {
        LAS float* sc = (LAS float*)(F.lds + RING_OFF);
        LAS float* red = (LAS float*)(F.lds + RING_OFF + 32768);
        float* ada = (float*)(F.ws + WS_ADA);
        if ((int)bid < 192) {
            for (int i = F.tid; i < 8192; i += 512) { const float v = I_c[i]; sc[i] = v / (1.0f + expf(-v)); }
            __syncthreads();
            for (int cb = bid; cb < 192; cb += F.G) {
                const int col = F.tid & 15, ks = F.tid >> 4;
                float a[8];
#pragma unroll
                for (int b = 0; b < 8; ++b) a[b] = 0.f;
                for (int kk = 0; kk < 32; ++kk) { const int k = ks * 32 + kk; const float w = I_w_ada[(size_t)k * 3072 + cb * 16 + col];
#pragma unroll
                    for (int b = 0; b < 8; ++b) a[b] += sc[b * 1024 + k] * w; }
#pragma unroll
                for (int b = 0; b < 8; ++b) red[(ks * 16 + col) * 8 + b] = a[b];
                __syncthreads();
                if (F.tid < 128) { const int c2 = F.tid & 15, b = F.tid >> 4; float s = 0.f; for (int k2 = 0; k2 < 32; ++k2) s += red[(k2 * 16 + c2) * 8 + b]; ada[b * 3072 + cb * 16 + c2] = s + I_b_ada[cb * 16 + c2]; }
                __syncthreads();
            }
        }
        __syncthreads();
    }
    {
        LAS float* scr = (LAS float*)(F.lds + RING_OFF + F.wave * 16384);
        const int gw = F.vcu * NWAVES + F.wave, NGW = F.G * NWAVES;
        constexpr int I_IN = (1024 / 64) * (8192 / 32), I_PA = (512 / 64) * (1024 / 32), I_PM = (1024 / 64) * (1024 / 32), I_OUT = I_PM, I_H = (256 / 64) * (256 / 32);
        constexpr int NITEMS = I_IN + I_PA + I_PM + I_OUT + 12 * I_H;
        bf16* WIN = (bf16*)(F.ws + WS_WIN); bf16* WPA = (bf16*)(F.ws + WS_WPA); bf16* WPM = (bf16*)(F.ws + WS_WPM); bf16* WOUT = (bf16*)(F.ws + WS_WOUT); bf16* WQKV = (bf16*)(F.ws + WS_WQKV);
        for (int it = gw; it < NITEMS; it += NGW) {
            int r = it;
            if (r < I_IN) { p0_transpose_item<true>(I_w_in, 1024, 8192, WIN, 0, scr, r, F.lane); continue; } r -= I_IN;
            if (r < I_PA) { p0_transpose_item<false>(I_w_pa, 512, 1024, WPA, 0, scr, r, F.lane); continue; } r -= I_PA;
            if (r < I_PM) { p0_transpose_item<false>(I_w_pm, 1024, 1024, WPM, 0, scr, r, F.lane); continue; } r -= I_PM;
            if (r < I_OUT) { p0_transpose_item<false>(I_w_out, 1024, 1024, WOUT, 0, scr, r, F.lane); continue; } r -= I_OUT;
            const int wh = r / I_H, ri = r % I_H, which = wh >> 2, head = wh & 3;
            const float* W = (which == 0 ? I_w_qm : (which == 1 ? I_w_km : I_w_vm)) + (size_t)head * 65536;
            p0_transpose_item<false>(W, 256, 256, WQKV, wh * 256, scr, ri, F.lane);
        }
    }
    {
        float* rope = (float*)(F.ws + WS_ROPE);
        for (int i = gtid; i < TT * 64; i += NT) { const int t = i >> 6, e = i & 63; double a = (double)I_pos[t] * inv2pi[e]; a -= __builtin_rint(a);
            const float ang = (float)a * 6.283185307179586f; f32x2 cs; cs.x = cosf(ang); cs.y = sinf(ang); *(f32x2*)(rope + (size_t)i * 2) = cs; }
    }
    {
        float* gwp = (float*)(F.ws + WS_GW);
        for (int i = gtid; i < 16384; i += NT) { const int which = i >> 13, c = (i >> 3) & 1023, j = i & 7, h = c >> 8;
            float s = 0.f;
            if (which == 0) { const float* wq = I_w_qm + (size_t)c * 256; const float* wk = I_w_km + (size_t)c * 256; float sq = 0.f, sk = 0.f;
                for (int e = 0; e < 256; ++e) { sq += wq[e] * I_w_if[(size_t)(h * 256 + e) * 8 + j]; sk += wk[e] * I_w_if[(size_t)(1024 + h * 256 + e) * 8 + j]; }
                s = sq + 0.0625f * sk; }
            else { const float* wv = I_w_vm + (size_t)c * 256; for (int e = 0; e < 256; ++e) s += wv[e] * I_w_if[(size_t)(2048 + h * 256 + e) * 8 + j]; }
            gwp[i] = s; }
    }
}
__device__ __forceinline__ bf16* h_row_ptr(Frame& F, int R) { return (bf16*)((unsigned char*)F.out + (size_t)(R / TH) * (64 * MiB)) + (size_t)(R % TH) * DM; }
__device__ __forceinline__ void p0b_lnmod(Frame& F, const float* x) {
    const int gw = F.vcu * NWAVES + F.wave, NGW = F.G * NWAVES;
    const float* ada = (const float*)(F.ws + WS_ADA);
    for (int R = gw; R < TT; R += NGW) {
        const GAS f32x4* xr = (const GAS f32x4*)(x + (size_t)R * DM) + F.lane;
        f32x4 v[4]; float s = 0.f;
#pragma unroll
        for (int j = 0; j < 4; ++j) { v[j] = xr[64 * j]; s += (v[j].x + v[j].y) + (v[j].z + v[j].w); }
        const float mean = wave_sum(s) * (1.f / DM); float s2 = 0.f;
#pragma unroll
        for (int j = 0; j < 4; ++j) { v[j] = v[j] - mean; s2 += (v[j].x * v[j].x + v[j].y * v[j].y) + (v[j].z * v[j].z + v[j].w * v[j].w); }
        const float rstd = 1.f / sqrtf(wave_sum(s2) * (1.f / DM) + LN_EPS);
        const int b = R >> 12; const f32x4* sh = (const f32x4*)(ada + (size_t)b * 3072) + F.lane; const f32x4* sc = (const f32x4*)(ada + (size_t)b * 3072 + 1024) + F.lane;
        GAS unsigned long long* o8 = (GAS unsigned long long*)h_row_ptr(F, R) + F.lane;
#pragma unroll
        for (int j = 0; j < 4; ++j) { const f32x4 a = sh[64 * j], m = sc[64 * j]; const f32x4 y = v[j] * rstd * (m + 1.0f) + a;
            o8[64 * j] = (unsigned long long)pk2(y.x, y.y) | ((unsigned long long)pk2(y.z, y.w) << 32); }
    }
}
__device__ __forceinline__ float logsigmoidf(float x) { return fminf(x, 0.f) - log1pf(expf(-fabsf(x))); }
__device__ __forceinline__ void p2a_conv(Frame& F, int half, const float* conv_w, const float* conv_b, const float* b_if, int bid) {
    const bf16* XM = (const bf16*)(F.ws + WS_XM); bf16* XC = (bf16*)(F.ws + WS_XC);
    float* gli = (float*)(F.ws + WS_GATES); float* glf = gli + (size_t)TT * 4;
    const float* gwp = (const float*)(F.ws + WS_GW);
    LAS float* red = (LAS float*)(F.lds + RING_OFF);
    const int cg = F.tid & 255, grp = F.tid >> 8, c0 = 4 * cg;
    float cw[4][4], cb[4], ga[4][8], gb[4][8];
#pragma unroll
    for (int j = 0; j < 4; ++j) { const f32x4 w = *(const f32x4*)(conv_w + j * 1024 + c0); cw[j][0] = w.x; cw[j][1] = w.y; cw[j][2] = w.z; cw[j][3] = w.w; }
    { const f32x4 w = *(const f32x4*)(conv_b + c0); cb[0] = w.x; cb[1] = w.y; cb[2] = w.z; cb[3] = w.w; }
#pragma unroll
    for (int ch = 0; ch < 4; ++ch)
#pragma unroll
        for (int j = 0; j < 8; ++j) { ga[ch][j] = gwp[(c0 + ch) * 8 + j]; gb[ch][j] = gwp[8192 + (c0 + ch) * 8 + j]; }
    for (int item = bid; item < TH / 64; item += F.G) {
        const int r0 = item * 64 + grp * 32; const int s0 = (half * TH + r0) & (SEQ - 1);
        float h1[4], h2[4], h3[4];
        if (s0 == 0) {
#pragma unroll
            for (int ch = 0; ch < 4; ++ch) { h1[ch] = 0.f; h2[ch] = 0.f; h3[ch] = 0.f; }
        } else {
            const v2u a1 = *(const v2u*)(XM + (size_t)(r0 - 1) * 1024 + c0), a2 = *(const v2u*)(XM + (size_t)(r0 - 2) * 1024 + c0), a3 = *(const v2u*)(XM + (size_t)(r0 - 3) * 1024 + c0);
            h1[0] = bflo(a1.x); h1[1] = bfhi(a1.x); h1[2] = bflo(a1.y); h1[3] = bfhi(a1.y);
            h2[0] = bflo(a2.x); h2[1] = bfhi(a2.x); h2[2] = bflo(a2.y); h2[3] = bfhi(a2.y);
            h3[0] = bflo(a3.x); h3[1] = bfhi(a3.x); h3[2] = bflo(a3.y); h3[3] = bfhi(a3.y);
        }
        for (int bt = 0; bt < 4; ++bt) {
            float acc[64];
#pragma unroll
            for (int i = 0; i < 64; ++i) acc[i] = 0.f;
#pragma unroll
            for (int tk = 0; tk < 8; ++tk) {
                const int r = r0 + bt * 8 + tk;
                const v2u xw = *(const v2u*)(XM + (size_t)r * 1024 + c0);
                float xv[4] = {bflo(xw.x), bfhi(xw.x), bflo(xw.y), bfhi(xw.y)}, xc[4];
#pragma unroll
                for (int ch = 0; ch < 4; ++ch) { const float pre = cb[ch] + cw[0][ch] * h3[ch] + cw[1][ch] * h2[ch] + cw[2][ch] * h1[ch] + cw[3][ch] * xv[ch];
                    xc[ch] = pre / (1.0f + __expf(-pre)); h3[ch] = h2[ch]; h2[ch] = h1[ch]; h1[ch] = xv[ch]; }
                v2u ow; ow.x = pk2(xc[0], xc[1]); ow.y = pk2(xc[2], xc[3]);
                *(v2u*)(XC + (size_t)r * 1024 + c0) = ow;
#pragma unroll
                for (int j = 0; j < 8; ++j) { float s = 0.f;
#pragma unroll
                    for (int ch = 0; ch < 4; ++ch) s += xc[ch] * ga[ch][j] + xv[ch] * gb[ch][j];
                    acc[tk * 8 + j] = s; }
            }
#define RS_STEP(H) { const bool up = (F.lane & (H)) != 0; _Pragma("unroll") for (int i = 0; i < (H); ++i) { const float a = acc[i], b = acc[i + (H)]; const float keep = up ? b : a, send = up ? a : b; acc[i] = keep + __shfl_xor(send, (H)); } }
            RS_STEP(32) RS_STEP(16) RS_STEP(8) RS_STEP(4) RS_STEP(2) RS_STEP(1)
#undef RS_STEP
            red[F.wave * 64 + F.lane] = acc[0];
            __syncthreads();
            if ((F.wave & 3) == 0) { const int wb = F.wave * 64 + F.lane; const float v = (red[wb] + red[wb + 64]) + (red[wb + 128] + red[wb + 192]);
                const int tk = F.lane >> 3, j = F.lane & 7; const size_t R = (size_t)half * TH + r0 + bt * 8 + tk; const float g = v + b_if[j];
                if (j < 4) gli[R * 4 + j] = g; else glf[R * 4 + (j - 4)] = logsigmoidf(g); }
            __syncthreads();
        }
    }
}
__device__ __forceinline__ void p3_attention_simple(Frame& F, int half) {
    const bf16* QA = (const bf16*)(F.ws + WS_QA); const bf16* KA = (const bf16*)(F.ws + WS_KA); const bf16* VA = (const bf16*)(F.ws + WS_VA); const bf16* ZA = (const bf16*)(F.ws + WS_ZA);
    bf16* ATG = (bf16*)(F.ws + WS_OG);
    const int gw = F.vcu * NWAVES + F.wave, NGW = F.G * NWAVES, d = 2 * F.lane;
    for (int item = gw; item < TH * 4; item += NGW) {
        const int r = item >> 2, h = item & 3, s = (half * TH + r) & (SEQ - 1);
        float m = -1e30f, l = 0.f, o0 = 0.f, o1 = 0.f;
        for (int g = 0; g < 3; ++g) { const int dil = 1 << (2 * g);
            const unsigned qw = *(const unsigned*)(QA + (size_t)r * 1536 + (g * 4 + h) * 128 + d); const float q0 = bflo(qw), q1 = bfhi(qw);
            int nk = s / dil; if (nk > 128) nk = 128;
            for (int j = 0; j <= nk; ++j) { const size_t rk = (size_t)(r - j * dil);
                const unsigned kw = *(const unsigned*)(KA + rk * 512 + h * 128 + d); const unsigned vw = *(const unsigned*)(VA + rk * 512 + h * 128 + d);
                const float dot = wave_sum(q0 * bflo(kw) + q1 * bfhi(kw)) * ATT_SCALE;
                const float mn = fmaxf(m, dot), al = __expf(m - mn), p = __expf(dot - mn);
                l = l * al + p; o0 = o0 * al + p * bflo(vw); o1 = o1 * al + p * bfhi(vw); m = mn; } }
        const unsigned zw = *(const unsigned*)(ZA + (size_t)r * 512 + h * 128 + d); const float il = 1.0f / l;
        *(unsigned*)(ATG + (size_t)r * 512 + h * 128 + d) = pk2(o0 * il * bflo(zw), o1 * il * bfhi(zw));
    }
}
__device__ __forceinline__ void p3_chain_simple(Frame& F, int half, int bid) {
    const bf16* QM = (const bf16*)(F.ws + WS_QM); const bf16* KM = (const bf16*)(F.ws + WS_KM); const bf16* VM = (const bf16*)(F.ws + WS_VM); const bf16* OM = (const bf16*)(F.ws + WS_OM);
    bf16* Y = (bf16*)(F.ws + WS_Y);
    const float* gli = (const float*)(F.ws + WS_GATES); const float* glf = gli + (size_t)TT * 4;
    const int dd = F.tid >> 4, ec = F.tid & 15;
    for (int ch = bid; ch < 128; ch += F.G) {
        const int bl = ch >> 5, h = (ch >> 3) & 3, ds = ch & 7, c = h * 256 + ds * 32 + dd, eb = h * 256 + ec * 16;
        float C[16], n[16], m = 0.f;
#pragma unroll
        for (int i = 0; i < 16; ++i) { C[i] = 0.f; n[i] = 0.f; }
        for (int t = 0; t < SEQ; ++t) { const size_t r = (size_t)bl * SEQ + t, R = (size_t)half * TH + r;
            const float li = gli[R * 4 + h], lf = glf[R * 4 + h];
            const v4u k0 = *(const v4u*)(KM + r * 1024 + eb), k1 = *(const v4u*)(KM + r * 1024 + eb + 8), q0 = *(const v4u*)(QM + r * 1024 + eb), q1 = *(const v4u*)(QM + r * 1024 + eb + 8);
            const float v = bf2f(VM[r * 1024 + c]);
            const float mn = fmaxf(lf + m, li), fp = __expf(lf + m - mn), ip = __expf(li - mn);
            float kk[16] = {bflo(k0.x), bfhi(k0.x), bflo(k0.y), bfhi(k0.y), bflo(k0.z), bfhi(k0.z), bflo(k0.w), bfhi(k0.w), bflo(k1.x), bfhi(k1.x), bflo(k1.y), bfhi(k1.y), bflo(k1.z), bfhi(k1.z), bflo(k1.w), bfhi(k1.w)};
            float qq[16] = {bflo(q0.x), bfhi(q0.x), bflo(q0.y), bfhi(q0.y), bflo(q0.z), bfhi(q0.z), bflo(q0.w), bfhi(q0.w), bflo(q1.x), bfhi(q1.x), bflo(q1.y), bfhi(q1.y), bflo(q1.z), bfhi(q1.z), bflo(q1.w), bfhi(q1.w)};
            float num = 0.f, den = 0.f; const float iv = ip * v;
#pragma unroll
            for (int i = 0; i < 16; ++i) { C[i] = fp * C[i] + iv * kk[i]; n[i] = fp * n[i] + ip * kk[i]; num += C[i] * qq[i]; den += n[i] * qq[i]; }
#pragma unroll
            for (int o = 1; o < 16; o <<= 1) { num += __shfl_xor(num, o); den += __shfl_xor(den, o); }
            const float hv = num / fmaxf(fabsf(den), __expf(-mn)); m = mn;
            if (ec == 0) Y[r * 1024 + c] = (bf16)f2bf(bf2f(OM[r * 1024 + c]) * hv);
        }
    }
}
template <bool MERGE>
__device__ __forceinline__ void p4a_finalize(Frame& F, int half, const float* mh_norm_w, const float* skip_m) {
    const bf16* Y = (const bf16*)(F.ws + WS_Y); const bf16* XC = (const bf16*)(F.ws + WS_XC); const bf16* ZM = (const bf16*)(F.ws + WS_ZM); bf16* HMG = (bf16*)(F.ws + WS_HMG);
    const bf16* OG = (const bf16*)(F.ws + WS_OG); const bf16* ZA = (const bf16*)(F.ws + WS_ZA); const float* LSE = (const float*)(F.ws + WS_LSE); bf16* ATG = (bf16*)(F.ws + WS_ATG);
    const int gw = F.vcu * NWAVES + F.wave, NGW = F.G * NWAVES, c16 = 16 * F.lane, c8 = 8 * F.lane, hd = F.lane >> 4;
    float nw[16], sk[16];
#pragma unroll
    for (int i = 0; i < 16; ++i) { nw[i] = mh_norm_w[c16 + i]; sk[i] = skip_m[c16 + i]; }
    for (int r = gw; r < TH; r += NGW) {
        { const v4u y0 = *(const v4u*)(Y + (size_t)r * 1024 + c16), y1 = *(const v4u*)(Y + (size_t)r * 1024 + c16 + 8);
          float y[16] = {bflo(y0.x), bfhi(y0.x), bflo(y0.y), bfhi(y0.y), bflo(y0.z), bfhi(y0.z), bflo(y0.w), bfhi(y0.w), bflo(y1.x), bfhi(y1.x), bflo(y1.y), bfhi(y1.y), bflo(y1.z), bfhi(y1.z), bflo(y1.w), bfhi(y1.w)};
          float s = 0.f;
#pragma unroll
          for (int i = 0; i < 16; ++i) s += y[i];
#pragma unroll
          for (int o = 1; o < 16; o <<= 1) s += __shfl_xor(s, o);
          const float mu = s * (1.f / 256.f); float q = 0.f;
#pragma unroll
          for (int i = 0; i < 16; ++i) { y[i] -= mu; q += y[i] * y[i]; }
#pragma unroll
          for (int o = 1; o < 16; o <<= 1) q += __shfl_xor(q, o);
          const float rstd = 1.f / sqrtf(q * (1.f / 256.f) + LN_EPS);
          const v4u x0 = *(const v4u*)(XC + (size_t)r * 1024 + c16), x1 = *(const v4u*)(XC + (size_t)r * 1024 + c16 + 8), z0 = *(const v4u*)(ZM + (size_t)r * 1024 + c16), z1 = *(const v4u*)(ZM + (size_t)r * 1024 + c16 + 8);
          const float xx[16] = {bflo(x0.x), bfhi(x0.x), bflo(x0.y), bfhi(x0.y), bflo(x0.z), bfhi(x0.z), bflo(x0.w), bfhi(x0.w), bflo(x1.x), bfhi(x1.x), bflo(x1.y), bfhi(x1.y), bflo(x1.z), bfhi(x1.z), bflo(x1.w), bfhi(x1.w)};
          const float zz[16] = {bflo(z0.x), bfhi(z0.x), bflo(z0.y), bfhi(z0.y), bflo(z0.z), bfhi(z0.z), bflo(z0.w), bfhi(z0.w), bflo(z1.x), bfhi(z1.x), bflo(z1.y), bfhi(z1.y), bflo(z1.z), bfhi(z1.z), bflo(z1.w), bfhi(z1.w)};
          float o[16];
#pragma unroll
          for (int i = 0; i < 16; ++i) o[i] = (y[i] * rstd * nw[i] + sk[i] * xx[i]) * zz[i];
          v4u w0, w1; w0.x = pk2(o[0], o[1]); w0.y = pk2(o[2], o[3]); w0.z = pk2(o[4], o[5]); w0.w = pk2(o[6], o[7]); w1.x = pk2(o[8], o[9]); w1.y = pk2(o[10], o[11]); w1.z = pk2(o[12], o[13]); w1.w = pk2(o[14], o[15]);
          *(v4u*)(HMG + (size_t)r * 1024 + c16) = w0; *(v4u*)(HMG + (size_t)r * 1024 + c16 + 8) = w1; }
        if constexpr (MERGE) {
            const float l0 = LSE[(size_t)r * 4 + hd], l1 = LSE[(size_t)(TH + r) * 4 + hd], l2 = LSE[(size_t)(2 * TH + r) * 4 + hd];
            const float mx = fmaxf(l0, fmaxf(l1, l2)); float w0 = __expf(l0 - mx), w1 = __expf(l1 - mx), w2 = __expf(l2 - mx); const float iw = 1.f / (w0 + w1 + w2); w0 *= iw; w1 *= iw; w2 *= iw;
            const v4u a = *(const v4u*)(OG + (size_t)r * 512 + c8), b = *(const v4u*)(OG + (size_t)(TH + r) * 512 + c8), c = *(const v4u*)(OG + (size_t)(2 * TH + r) * 512 + c8), z = *(const v4u*)(ZA + (size_t)r * 512 + c8);
            v4u o;
            o.x = pk2((w0 * bflo(a.x) + w1 * bflo(b.x) + w2 * bflo(c.x)) * bflo(z.x), (w0 * bfhi(a.x) + w1 * bfhi(b.x) + w2 * bfhi(c.x)) * bfhi(z.x));
            o.y = pk2((w0 * bflo(a.y) + w1 * bflo(b.y) + w2 * bflo(c.y)) * bflo(z.y), (w0 * bfhi(a.y) + w1 * bfhi(b.y) + w2 * bfhi(c.y)) * bfhi(z.y));
            o.z = pk2((w0 * bflo(a.z) + w1 * bflo(b.z) + w2 * bflo(c.z)) * bflo(z.z), (w0 * bfhi(a.z) + w1 * bfhi(b.z) + w2 * bfhi(c.z)) * bfhi(z.z));
            o.w = pk2((w0 * bflo(a.w) + w1 * bflo(b.w) + w2 * bflo(c.w)) * bflo(z.w), (w0 * bfhi(a.w) + w1 * bfhi(b.w) + w2 * bfhi(c.w)) * bfhi(z.w));
            *(v4u*)(ATG + (size_t)r * 512 + c8) = o;
        }
    }
}
__device__ __forceinline__ void p5b_ln(Frame& F, int half, const float* ln_g, const float* ln_b) {
    const int gw = F.vcu * NWAVES + F.wave, NGW = F.G * NWAVES;
    f32x4 g4[4], b4[4];
#pragma unroll
    for (int j = 0; j < 4; ++j) { g4[j] = ((const f32x4*)ln_g)[F.lane + 64 * j]; b4[j] = ((const f32x4*)ln_b)[F.lane + 64 * j]; }
    for (int r = gw; r < TH; r += NGW) {
        GAS f32x4* xr = (GAS f32x4*)(F.out + ((size_t)half * TH + r) * DM) + F.lane;
        f32x4 v[4]; float s = 0.f;
#pragma unroll
        for (int j = 0; j < 4; ++j) { v[j] = xr[64 * j]; s += (v[j].x + v[j].y) + (v[j].z + v[j].w); }
        const float mean = wave_sum(s) * (1.f / DM); float s2 = 0.f;
#pragma unroll
        for (int j = 0; j < 4; ++j) { v[j] = v[j] - mean; s2 += (v[j].x * v[j].x + v[j].y * v[j].y) + (v[j].z * v[j].z + v[j].w * v[j].w); }
        const float rstd = 1.f / sqrtf(wave_sum(s2) * (1.f / DM) + LN_EPS);
#pragma unroll
        for (int j = 0; j < 4; ++j) xr[64 * j] = v[j] * rstd * g4[j] + b4[j];
    }
}
#ifndef ONE_LAUNCH
#define ONE_LAUNCH 0
#endif
#ifndef ATT_SIMPLE
#define ATT_SIMPLE 1
#endif
#ifndef CHAIN_SIMPLE
#define CHAIN_SIMPLE 1
#endif
constexpr int NPH = 10;
struct Args { const void* in[20]; float* out; unsigned char* ws; RopeTab rt; int ph_lo, ph_hi, h_lo, h_hi, one_launch, pad; };
__global__ void __launch_bounds__(NWAVES * 64, 2) hyb_fwd(Args args) {
    extern __shared__ __attribute__((aligned(16))) unsigned char lds[];
    Frame F;
    F.lds = (LAS unsigned char*)lds;
    F.MISC = (volatile LAS unsigned*)(F.lds + MISC_OFF);
    F.tid = threadIdx.x; F.lane = F.tid & 63; F.wave = __builtin_amdgcn_readfirstlane(F.tid >> 6);
    F.G = gridDim.x; { const int bx = blockIdx.x; F.vcu = (F.G % 8 == 0) ? (bx % 8) * (F.G / 8) + bx / 8 : bx; }
    F.ws = args.ws; F.ctl = (gu32*)(args.ws + WS_CTL);
    F.out = args.out;
#define INF(k) ((const float*)args.in[k])
    for (int u = F.tid; u < (LDS_BYTES - LDSCTL_OFF) / 4; u += NWAVES * 64) ((LAS unsigned*)(F.lds + LDSCTL_OFF))[u] = 0u;
    __syncthreads();
    XcdBarrier bar; bar.bar = (unsigned*)(F.ctl + CW_BAR); bar.x = 0; bar.st = nullptr;
    if (args.one_launch) bar = xcd_barrier_post((unsigned*)(F.ctl + CW_BAR), F.MISC + 8);
#define GRID_BAR() do { if (args.one_launch) xcd_barrier(bar); } while (0)
    const int lo = args.ph_lo, hi = args.ph_hi;
#ifndef PHASE_MASK
#define PHASE_MASK 0x3ff
#endif
#define IN(k) (((PHASE_MASK >> (k)) & 1) && lo <= (k) && (k) < hi)
#define PHASE_BEGIN() do { int t_ = threadIdx.x, b_ = blockIdx.x; asm volatile("" : "+v"(t_)); asm volatile("" : "+s"(b_)); F.tid = t_; F.lane = t_ & 63; F.wave = __builtin_amdgcn_readfirstlane(t_ >> 6); bid = b_; \
        F.vcu = (F.G % 8 == 0) ? (b_ % 8) * (F.G / 8) + b_ / 8 : b_; } while (0)
    int bid = blockIdx.x;
    if (IN(0)) { PHASE_BEGIN(); p0a_prologue(F, INF(1), INF(3), INF(4), INF(5), INF(8), INF(9), INF(10), INF(11), INF(15), INF(16), INF(17), (const int*)args.in[2], args.rt.inv2pi, bid); GRID_BAR(); }
    if (IN(1)) { PHASE_BEGIN(); p0b_lnmod(F, INF(0)); GRID_BAR(); }
    for (int half = args.h_lo; half < args.h_hi; ++half) {
        if (IN(2)) { PHASE_BEGIN();
            pg8::Gemm g{1024, 1024, 1024}; pg8::PlainOrder S; S.init(TH / 256, INW / 256, F.G, bid);
            S.set((unsigned char*)F.out + (size_t)half * (64 * MiB), F.ws + WS_WIN, 1024, 1024);
            pg8::EpiProj E{F.ws, (const float*)(F.ws + WS_ROPE) + (size_t)half * TH * 128};
            pg8::gemm_phase<pg8::EpiProj, pg8::PlainOrder, true, true>(F.lds + RING_OFF, g, S, E, F.tid);
            GRID_BAR();
        }
        if (IN(3)) { PHASE_BEGIN(); p2a_conv(F, half, INF(6), INF(7), INF(12), bid); GRID_BAR(); }
        if (IN(4)) { PHASE_BEGIN();
            int kq_ = 256; asm volatile("" : "+s"(kq_)); pg8::Gemm g{1024, 256, kq_}; pg8::QkvOrder S; S.init(TH / 256, 12, F.G, bid);
            S.ws = (const char*)F.ws;
            pg8::EpiQkv E{F.ws};
            pg8::gemm_phase<pg8::EpiQkv, pg8::QkvOrder, true, true>(F.lds + RING_OFF, g, S, E, F.tid);
            GRID_BAR();
        }
        if (IN(5)) { PHASE_BEGIN();
#if CHAIN_SIMPLE
            p3_chain_simple(F, half, bid);
#endif
#if ATT_SIMPLE
            p3_attention_simple(F, half);
#endif
            GRID_BAR();
        }
        if (IN(6)) { PHASE_BEGIN(); p4a_finalize<!ATT_SIMPLE>(F, half, INF(13), INF(14)); GRID_BAR(); }
        if (IN(7)) { PHASE_BEGIN();
            bf16* MRG = (bf16*)(F.ws + WS_MRG);
            { pg8::Gemm g{512, 512, 512}; pg8::PlainOrder S; S.init(TH / 256, 4, F.G, bid); S.set(F.ws + (ATT_SIMPLE ? WS_OG : WS_ATG), F.ws + WS_WPA, 512, 512);
              pg8::EpiGate<0> E{(const bf16*)(F.ws + WS_GA), MRG}; pg8::gemm_phase<pg8::EpiGate<0>, pg8::PlainOrder, false, true>(F.lds + RING_OFF, g, S, E, F.tid); }
            PHASE_BEGIN();
            { pg8::Gemm g{1024, 1024, 1024}; pg8::PlainOrder S; S.init(TH / 256, 4, F.G, bid); S.set(F.ws + WS_HMG, F.ws + WS_WPM, 1024, 1024);
              pg8::EpiGate<1> E{(const bf16*)(F.ws + WS_GM), MRG}; pg8::gemm_phase<pg8::EpiGate<1>, pg8::PlainOrder, false, true>(F.lds + RING_OFF, g, S, E, F.tid); }
            GRID_BAR();
        }
        if (IN(8)) { PHASE_BEGIN();
            pg8::Gemm g{1024, 1024, 1024}; pg8::PlainOrder S; S.init(TH / 256, 4, F.G, bid); S.set(F.ws + WS_MRG, F.ws + WS_WOUT, 1024, 1024);
            pg8::EpiRes E{INF(0) + (size_t)half * TH * DM, F.out + (size_t)half * TH * DM, (const float*)(F.ws + WS_ADA) + 2048, half * TH, 1.189207115002721f};
            pg8::gemm_phase<pg8::EpiRes, pg8::PlainOrder, false, true>(F.lds + RING_OFF, g, S, E, F.tid);
            GRID_BAR();
        }
        if (IN(9)) { PHASE_BEGIN(); p5b_ln(F, half, INF(18), INF(19)); }
    }
#undef IN
#undef GRID_BAR
}

extern "C" void kernel_launch(void* const* d_in, const int* in_sizes, int n_in, void* d_out, int out_size, void* d_ws, size_t ws_size, hipStream_t stream) {
    static int grid = 0;
    if (grid == 0) {
        if (n_in != 20 || in_sizes[0] != TT * DM || out_size != TT * DM || ws_size < WS_END) { fprintf(stderr, "kernel_launch: unexpected shapes (n_in %d, in0 %d, out %d, ws %zu); nothing launched\n", n_in, n_in > 0 ? in_sizes[0] : -1, out_size, ws_size); grid = -1; return; }
        int dev = 0, cus = 0;
        if (hipGetDevice(&dev) != hipSuccess || hipDeviceGetAttribute(&cus, hipDeviceAttributeMultiprocessorCount, dev) != hipSuccess) { grid = -1; return; }
        if (hipFuncSetAttribute((const void*)hyb_fwd, hipFuncAttributeMaxDynamicSharedMemorySize, LDS_BYTES) != hipSuccess) { fprintf(stderr, "kernel_launch: hipFuncSetAttribute failed\n"); grid = -1; return; }
        int per_cu = 0;
        if (hipOccupancyMaxActiveBlocksPerMultiprocessor(&per_cu, (const void*)hyb_fwd, NWAVES * 64, LDS_BYTES) != hipSuccess || per_cu < 1) fprintf(stderr, "kernel_launch: occupancy query says %d\n", per_cu);
        (void)hipGetLastError();
        grid = cus;
    }
    if (grid < 0) return;
    if (hipMemsetAsync((char*)d_ws + WS_CTL, 0, CTL_ZERO_BYTES, stream) != hipSuccess) return;
    Args a; memset(&a, 0, sizeof(a));
    for (int i = 0; i < 20; ++i) a.in[i] = d_in[i];
    a.out = (float*)d_out; a.ws = (unsigned char*)d_ws;
    for (int e = 0; e < 64; ++e) a.rt.inv2pi[e] = pow(10000.0, -(double)e / 64.0) / 6.283185307179586476925286766559;
#if ONE_LAUNCH
    a.ph_lo = 0; a.ph_hi = NPH; a.h_lo = 0; a.h_hi = NHALF; a.one_launch = 1;
    hipLaunchKernelGGL(hyb_fwd, dim3(grid), dim3(NWAVES * 64), LDS_BYTES, stream, a);
#else
    a.one_launch = 0;
    for (int p = 0; p < 2; ++p) { a.ph_lo = p; a.ph_hi = p + 1; a.h_lo = 0; a.h_hi = 0; hipLaunchKernelGGL(hyb_fwd, dim3(grid), dim3(NWAVES * 64), LDS_BYTES, stream, a); }
    for (int h = 0; h < NHALF; ++h)
        for (int p = 2; p < NPH; ++p) { a.ph_lo = p; a.ph_hi = p + 1; a.h_lo = h; a.h_hi = h + 1; hipLaunchKernelGGL(hyb_fwd, dim3(grid), dim3(NWAVES * 64), LDS_BYTES, stream, a); }
#endif
    const hipError_t le = hipPeekAtLastError();
    if (le != hipSuccess) fprintf(stderr, "kernel_launch: launch failed: %s\n", hipGetErrorName(le));
}
```

```cpp
#define ONE_LAUNCH 1
#include <hip/hip_runtime.h>
#include <cstdio>
#include <cstdint>
#include <cstring>
#include <cmath>
constexpr int BATCH = 8, SEQ = 4096, DM = 1024, TT = BATCH * SEQ, NHALF = 2, TH = TT / NHALF, INW = 8192;
constexpr int MH = 4, MHD = 256, MCHUNK = 128;
constexpr float LN_EPS = 1e-5f;
constexpr float ATT_SCALE = 0.08838834764831845f;
constexpr int NWAVES = 8;
constexpr size_t MiB = 1u << 20;
constexpr size_t WS_CTL = 0, CTL_ZERO_BYTES = 1 * MiB;
constexpr size_t WS_ADA = 1 * MiB;
constexpr size_t WS_GW = 1 * MiB + 128 * 1024;
constexpr size_t WS_GATES = 2 * MiB;
constexpr size_t WS_LSE = 3 * MiB;
constexpr size_t WS_WIN = 4 * MiB, WS_WPA = 20 * MiB, WS_WPM = 21 * MiB, WS_WOUT = 23 * MiB, WS_WQKV = 25 * MiB;
constexpr size_t WS_ROPE = 27 * MiB;
constexpr size_t WS_QA = 44 * MiB, WS_KA = 92 * MiB, WS_VA = 108 * MiB, WS_ZA = 124 * MiB, WS_XM = 140 * MiB, WS_ZM = 172 * MiB, WS_OM = 204 * MiB, WS_GA = 236 * MiB, WS_GM = 268 * MiB;
constexpr size_t WS_XC = 300 * MiB, WS_QM = 332 * MiB, WS_KM = 364 * MiB, WS_VM = 396 * MiB, WS_OG = 428 * MiB, WS_END = 476 * MiB;
constexpr size_t WS_Y = WS_XM;
constexpr size_t WS_HMG = WS_QA;
constexpr size_t WS_ATG = WS_KA;
constexpr size_t WS_MRG = WS_QM;
constexpr int CW_TMO = 0, CW_CODE = 1;
constexpr int CW_BAR = 4096;
constexpr int CW_QUEUE = 16384;
constexpr int RING_OFF = 0, RING_BYTES = 131072;
constexpr int LDSCTL_OFF = RING_BYTES, MISC_OFF = LDSCTL_OFF + 320;
constexpr int LDS_BYTES = 147456;
static_assert(MISC_OFF + 128 <= LDS_BYTES, "LDS map");

namespace pg8 {
#define PG8_LAS __attribute__((address_space(3)))
typedef unsigned short bf16_t;
typedef short bf16x8 __attribute__((ext_vector_type(8)));
typedef float f32x4 __attribute__((ext_vector_type(4)));
typedef float f32x2 __attribute__((ext_vector_type(2)));
typedef unsigned u32x4 __attribute__((ext_vector_type(4)));
typedef unsigned u32x2 __attribute__((ext_vector_type(2)));
constexpr int BM = 256, BK = 64, HALF = 128, HTB = HALF * BK * 2  , STAGE_BYTES = 8 * HTB, NXCD = 8, WGM = 8;

__host__ __device__ __forceinline__ int lds_byte(int r, int c) { const int st = (r >> 4) * 2 + (c >> 5), rr = r & 15, cc = c & 31, ob = rr * 64 + cc * 2; return st * 1024 + (ob ^ (((ob >> 9) & 1) << 5)); }
__host__ __device__ __forceinline__ void stage_rc(int b, int& R, int& C) { const int st = b / 1024, sb = b % 1024, swz = sb ^ (((sb >> 9) & 1) << 5); R = (st >> 1) * 16 + swz / 64; C = (st & 1) * 32 + (swz % 64) / 2; }
__host__ __device__ __forceinline__ int perm32(int rho) { const int n = rho >> 4, i = rho & 15; return 8 * (i >> 2) + 4 * n + (i & 3); }

struct Unit { int pm, pn; const char* a; const char* b; };
struct Gemm { int lda, ldb, K; };

struct OrderBase {
    int nM, nN, nwg, G, c;
    __device__ void init(int nM_, int nN_, int G_, int c_) { nM = nM_; nN = nN_; nwg = nM * nN; G = G_; c = c_; }
    __device__ bool tile(int i, int& pm, int& pn) const {
        const long L = (long)i * G + c; if (L >= nwg) return false;
        int wgid = (int)L; { const int q = nwg / NXCD, r = nwg % NXCD, xcd = wgid % NXCD, off = wgid / NXCD; wgid = (xcd < r ? xcd * (q + 1) : r * (q + 1) + (xcd - r) * q) + off; }
        const int nig = WGM * nN, gid = wgid / nig, fm = gid * WGM, gsz = (nM - fm) < WGM ? (nM - fm) : WGM;
        pm = fm + ((wgid % nig) % gsz); pn = (wgid % nig) / gsz; return true;
    }
};
struct PlainOrder : OrderBase {
    const char* A; const char* Bt; size_t astep, bstep;
    __device__ void set(const void* A_, const void* Bt_, int lda, int ldb) { A = (const char*)A_; Bt = (const char*)Bt_; astep = (size_t)256 * lda * 2; bstep = (size_t)256 * ldb * 2; }
    __device__ bool next(int i, Unit& u) const { if (!tile(i, u.pm, u.pn)) return false; u.a = A + (size_t)u.pm * astep; u.b = Bt + (size_t)u.pn * bstep; return true; }
    __device__ __forceinline__ void a_ready(const Unit&) const {}
    __device__ __forceinline__ void done(const Unit&) const {}
};
struct QkvOrder : OrderBase {
    const char* ws;
    __device__ bool next(int i, Unit& u) const { if (!tile(i, u.pm, u.pn)) return false; const int which = u.pn >> 2, head = u.pn & 3;
        u.a = ws + (which < 2 ? WS_XC : WS_XM) + ((size_t)u.pm * 256 * 1024 + head * 256) * 2; u.b = ws + WS_WQKV + (size_t)u.pn * 256 * 256 * 2; return true; }
    __device__ __forceinline__ void a_ready(const Unit&) const {}
    __device__ __forceinline__ void done(const Unit&) const {}
};

__device__ __forceinline__ unsigned cvt_pk_bf16(float lo, float hi) { unsigned r; asm volatile("v_cvt_pk_bf16_f32 %0, %1, %2" : "=v"(r) : "v"(lo), "v"(hi)); return r; }
__device__ __forceinline__ float bf_lo(unsigned w) { return __uint_as_float(w << 16); }
__device__ __forceinline__ float bf_hi(unsigned w) { return __uint_as_float(w & 0xffff0000u); }
__device__ __forceinline__ float sigmoidf_fast(float v) { return __builtin_amdgcn_rcpf(1.0f + __builtin_amdgcn_exp2f(-1.4426950408889634f * v)); }


struct EpiProj {
    static constexpr bool PERM = true, AFTER_DRAIN = false;
    unsigned char* ws;
    const float* rope;
    __device__ __forceinline__ void operator()(const f32x4 (&acc)[2][2][4][2], const Unit& u, int wr, int wc, int fr, int fq) const {
        const int row0 = u.pm * BM + wr * 64 + fr; const int pn = u.pn;
        if (pn < 8) {
            const int hl = wc >> 1, e0 = 32 * (wc & 1) + 8 * fq;
            bf16_t* base; int ld;
            if (pn < 6) { base = (bf16_t*)(ws + WS_QA) + (pn * 2 + hl) * 128 + e0; ld = 1536; } else { base = (bf16_t*)(ws + WS_KA) + ((pn - 6) * 2 + hl) * 128 + e0; ld = 512; }
#pragma unroll
            for (int ai = 0; ai < 2; ++ai)
#pragma unroll
                for (int m = 0; m < 4; ++m) { const int r = row0 + ai * HALF + m * 16;
                    const f32x4* tb = (const f32x4*)(rope + (size_t)r * 128 + e0 * 2);
                    const f32x4 t0 = tb[0], t1 = tb[1], t2 = tb[2], t3 = tb[3];
                    const f32x4 x1a = acc[ai][0][m][0], x1b = acc[ai][0][m][1], x2a = acc[ai][1][m][0], x2b = acc[ai][1][m][1];
                    float o1[8], o2[8];
                    o1[0] = x1a[0] * t0[0] - x2a[0] * t0[1]; o2[0] = x2a[0] * t0[0] + x1a[0] * t0[1];
                    o1[1] = x1a[1] * t0[2] - x2a[1] * t0[3]; o2[1] = x2a[1] * t0[2] + x1a[1] * t0[3];
                    o1[2] = x1a[2] * t1[0] - x2a[2] * t1[1]; o2[2] = x2a[2] * t1[0] + x1a[2] * t1[1];
                    o1[3] = x1a[3] * t1[2] - x2a[3] * t1[3]; o2[3] = x2a[3] * t1[2] + x1a[3] * t1[3];
                    o1[4] = x1b[0] * t2[0] - x2b[0] * t2[1]; o2[4] = x2b[0] * t2[0] + x1b[0] * t2[1];
                    o1[5] = x1b[1] * t2[2] - x2b[1] * t2[3]; o2[5] = x2b[1] * t2[2] + x1b[1] * t2[3];
                    o1[6] = x1b[2] * t3[0] - x2b[2] * t3[1]; o2[6] = x2b[2] * t3[0] + x1b[2] * t3[1];
                    o1[7] = x1b[3] * t3[2] - x2b[3] * t3[3]; o2[7] = x2b[3] * t3[2] + x1b[3] * t3[3];
                    u32x4 w1, w2;
                    w1.x = cvt_pk_bf16(o1[0], o1[1]); w1.y = cvt_pk_bf16(o1[2], o1[3]); w1.z = cvt_pk_bf16(o1[4], o1[5]); w1.w = cvt_pk_bf16(o1[6], o1[7]);
                    w2.x = cvt_pk_bf16(o2[0], o2[1]); w2.y = cvt_pk_bf16(o2[2], o2[3]); w2.z = cvt_pk_bf16(o2[4], o2[5]); w2.w = cvt_pk_bf16(o2[6], o2[7]);
                    bf16_t* rp = base + (size_t)r * ld;
                    *(u32x4*)rp = w1; *(u32x4*)(rp + 64) = w2; }
        } else {
            bf16_t* base; int ld, act, ct;
            if (pn < 10)      { base = (bf16_t*)(ws + WS_VA); ld = 512;  act = 0; ct = pn - 8; }
            else if (pn < 12) { base = (bf16_t*)(ws + WS_ZA); ld = 512;  act = 1; ct = pn - 10; }
            else if (pn < 16) { base = (bf16_t*)(ws + WS_XM); ld = 1024; act = 0; ct = pn - 12; }
            else if (pn < 20) { base = (bf16_t*)(ws + WS_ZM); ld = 1024; act = 1; ct = pn - 16; }
            else if (pn < 24) { base = (bf16_t*)(ws + WS_OM); ld = 1024; act = 2; ct = pn - 20; }
            else if (pn < 28) { base = (bf16_t*)(ws + WS_GA); ld = 1024; act = 2; ct = pn - 24; }
            else              { base = (bf16_t*)(ws + WS_GM); ld = 1024; act = 2; ct = pn - 28; }
            const int col0 = ct * BM + wc * 32 + 8 * fq;
#pragma unroll
            for (int ai = 0; ai < 2; ++ai)
#pragma unroll
                for (int m = 0; m < 4; ++m) { bf16_t* rowp = base + (size_t)(row0 + ai * HALF + m * 16) * ld + col0;
#pragma unroll
                    for (int bj = 0; bj < 2; ++bj) { f32x4 v0 = acc[ai][bj][m][0], v1 = acc[ai][bj][m][1];
                        if (act != 0) {
#pragma unroll
                            for (int j = 0; j < 4; ++j) { const float s0 = sigmoidf_fast(v0[j]), s1 = sigmoidf_fast(v1[j]); v0[j] = (act == 1) ? v0[j] * s0 : s0; v1[j] = (act == 1) ? v1[j] * s1 : s1; } }
                        u32x4 w; w.x = cvt_pk_bf16(v0[0], v0[1]); w.y = cvt_pk_bf16(v0[2], v0[3]); w.z = cvt_pk_bf16(v1[0], v1[1]); w.w = cvt_pk_bf16(v1[2], v1[3]);
                        *(u32x4*)(rowp + bj * HALF) = w; } }
        }
    }
};
struct EpiQkv {
    static constexpr bool PERM = true, AFTER_DRAIN = false;
    unsigned char* ws;
    __device__ __forceinline__ void operator()(const f32x4 (&acc)[2][2][4][2], const Unit& u, int wr, int wc, int fr, int fq) const {
        const int which = u.pn >> 2, head = u.pn & 3; bf16_t* base = (bf16_t*)(ws + (which == 0 ? WS_QM : (which == 1 ? WS_KM : WS_VM))); const float sc = which == 1 ? 0.0625f : 1.0f;
        const int row0 = u.pm * BM + wr * 64 + fr, col0 = head * 256 + wc * 32 + 8 * fq;
#pragma unroll
        for (int ai = 0; ai < 2; ++ai)
#pragma unroll
            for (int m = 0; m < 4; ++m) { bf16_t* rowp = base + (size_t)(row0 + ai * HALF + m * 16) * 1024 + col0;
#pragma unroll
                for (int bj = 0; bj < 2; ++bj) { const f32x4 v0 = acc[ai][bj][m][0] * sc, v1 = acc[ai][bj][m][1] * sc;
                    u32x4 w; w.x = cvt_pk_bf16(v0[0], v0[1]); w.y = cvt_pk_bf16(v0[2], v0[3]); w.z = cvt_pk_bf16(v1[0], v1[1]); w.w = cvt_pk_bf16(v1[2], v1[3]);
                    *(u32x4*)(rowp + bj * HALF) = w; } }
    }
};
template <int MODE> struct EpiGate {
    static constexpr bool PERM = true, AFTER_DRAIN = false;
    const bf16_t* G; bf16_t* P;
    __device__ __forceinline__ void operator()(const f32x4 (&acc)[2][2][4][2], const Unit& u, int wr, int wc, int fr, int fq) const {
        const int row0 = u.pm * BM + wr * 64 + fr, col0 = u.pn * BM + wc * 32 + 8 * fq;
#pragma unroll
        for (int ai = 0; ai < 2; ++ai)
#pragma unroll
            for (int m = 0; m < 4; ++m) { const size_t off = (size_t)(row0 + ai * HALF + m * 16) * 1024 + col0;
#pragma unroll
                for (int bj = 0; bj < 2; ++bj) { const u32x4 g = *(const u32x4*)(G + off + bj * HALF); const f32x4 a0 = acc[ai][bj][m][0], a1 = acc[ai][bj][m][1];
                    float o[8];
                    o[0] = bf_lo(g.x) * a0[0]; o[1] = bf_hi(g.x) * a0[1]; o[2] = bf_lo(g.y) * a0[2]; o[3] = bf_hi(g.y) * a0[3];
                    o[4] = bf_lo(g.z) * a1[0]; o[5] = bf_hi(g.z) * a1[1]; o[6] = bf_lo(g.w) * a1[2]; o[7] = bf_hi(g.w) * a1[3];
                    if (MODE == 1) { const u32x4 p = *(const u32x4*)(P + off + bj * HALF);
                        o[0] += bf_lo(p.x); o[1] += bf_hi(p.x); o[2] += bf_lo(p.y); o[3] += bf_hi(p.y); o[4] += bf_lo(p.z); o[5] += bf_hi(p.z); o[6] += bf_lo(p.w); o[7] += bf_hi(p.w); }
                    u32x4 w; w.x = cvt_pk_bf16(o[0], o[1]); w.y = cvt_pk_bf16(o[2], o[3]); w.z = cvt_pk_bf16(o[4], o[5]); w.w = cvt_pk_bf16(o[6], o[7]);
                    *(u32x4*)(P + off + bj * HALF) = w; } }
    }
};
struct EpiRes {
    static constexpr bool PERM = false, AFTER_DRAIN = false;
    const float* x; float* out; const float* gate; int grow0; float alpha;
    __device__ __forceinline__ void operator()(const f32x4 (&acc)[2][2][4][2], const Unit& u, int wr, int wc, int fr, int fq) const {
        const int row0 = u.pm * BM + wr * 64 + fr, col0 = u.pn * BM + wc * 32 + 4 * fq;
        const int b = (grow0 + u.pm * BM) >> 12;
        f32x4 gv[2][2];
#pragma unroll
        for (int bj = 0; bj < 2; ++bj)
#pragma unroll
            for (int n = 0; n < 2; ++n) gv[bj][n] = *(const f32x4*)(gate + (size_t)b * 3072 + col0 + bj * HALF + n * 16);
#pragma unroll
        for (int ai = 0; ai < 2; ++ai)
#pragma unroll
            for (int m = 0; m < 4; ++m) { const size_t off = (size_t)(row0 + ai * HALF + m * 16) * 1024 + col0;
#pragma unroll
                for (int bj = 0; bj < 2; ++bj)
#pragma unroll
                    for (int n = 0; n < 2; ++n) { const f32x4 xv = *(const f32x4*)(x + off + bj * HALF + n * 16); *(f32x4*)(out + off + bj * HALF + n * 16) = xv * alpha + gv[bj][n] * acc[ai][bj][m][n]; } }
    }
};

template <class Epi, class Sched, bool ALIGN_EPI = false, bool SP2 = false>
__device__ __forceinline__ void gemm_phase(PG8_LAS unsigned char* lds, const Gemm g, const Sched& S, const Epi& E, const int tid) {
    const int wid = __builtin_amdgcn_readfirstlane(tid >> 6), lane = tid & 63, wr = wid >> 2, wc = wid & 3, fr = lane & 15, fq = lane >> 4;
    const int K = g.K, nt = K / BK;
    unsigned voffA[2], voffB[2];
#pragma unroll
    for (int i = 0; i < 2; ++i) { int R, C; stage_rc(tid * 16 + i * 8192, R, C); const int Rb = Epi::PERM ? ((R & ~31) + perm32(R & 31)) : R;
        voffA[i] = (unsigned)(R * g.lda + C) * 2u; voffB[i] = (unsigned)(Rb * g.ldb + C) * 2u; }
    const size_t kstep = (size_t)(BK * 2);
    const size_t hstepA = (size_t)HALF * g.lda * 2, hstepB = (size_t)HALF * g.ldb * 2;
    const unsigned ldsw = (unsigned)wid * 1024u;
    const int aoff = lds_byte(wr * 64 + fr, fq * 8), boff = lds_byte(wc * 32 + fr, fq * 8);
#define PG8_SA(b, h) (((b) * 2 + (h)) * HTB)
#define PG8_SB(b, h) ((4 + (b) * 2 + (h)) * HTB)
#define PG8_STAGE(bufoff, gbase, voff) do { _Pragma("unroll") for (int _i = 0; _i < 2; ++_i) \
        __builtin_amdgcn_global_load_lds((const unsigned*)((const char*)(gbase) + (voff)[_i]), (PG8_LAS unsigned*)(lds + (bufoff) + ldsw + _i * 8192), 16, 0, 0); } while (0)
#define PG8_LDA(dst, b, h) do { _Pragma("unroll") for (int m = 0; m < 4; ++m) _Pragma("unroll") for (int k = 0; k < 2; ++k) dst[m][k] = *(const PG8_LAS bf16x8*)(lds + PG8_SA(b, h) + aoff + m * 2048 + k * 1024); } while (0)
#define PG8_LDB(dst, b, h) do { _Pragma("unroll") for (int n = 0; n < 2; ++n) _Pragma("unroll") for (int k = 0; k < 2; ++k) dst[n][k] = *(const PG8_LAS bf16x8*)(lds + PG8_SB(b, h) + boff + n * 2048 + k * 1024); } while (0)
#define PG8_MMA(ai, bj, At, Bt) do { __builtin_amdgcn_s_setprio(1); _Pragma("unroll") for (int m = 0; m < 4; ++m) _Pragma("unroll") for (int n = 0; n < 2; ++n) _Pragma("unroll") for (int k = 0; k < 2; ++k) \
        acc[ai][bj][m][n] = __builtin_amdgcn_mfma_f32_16x16x32_bf16(Bt[n][k], At[m][k], acc[ai][bj][m][n], 0, 0, 0); __builtin_amdgcn_s_setprio(0); } while (0)
#define PG8_WAIT_V(n) asm volatile("s_waitcnt vmcnt(" #n ")" ::: "memory")
#define PG8_WAIT_L(n) asm volatile("s_waitcnt lgkmcnt(" #n ")" ::: "memory")
#define PG8_BAR __builtin_amdgcn_s_barrier()
#define PG8_SCHED __builtin_amdgcn_sched_barrier(0)
    Unit cur, nxt; int ui = 0;
    if (!S.next(0, cur)) return;
    f32x4 acc[2][2][4][2];
#pragma unroll
    for (int a = 0; a < 2; ++a)
#pragma unroll
        for (int b = 0; b < 2; ++b)
#pragma unroll
            for (int m = 0; m < 4; ++m)
#pragma unroll
                for (int n = 0; n < 2; ++n) acc[a][b][m][n] = (f32x4){0.f, 0.f, 0.f, 0.f};
    bf16x8 At[4][2], B0[2][2], B1[2][2];
    const char* cA = cur.a; const char* cB = cur.b;
    S.a_ready(cur);
    if constexpr (SP2) {
        PG8_STAGE(PG8_SB(0, 0), cB, voffB); PG8_STAGE(PG8_SB(0, 1), cB + hstepB, voffB); PG8_STAGE(PG8_SA(0, 0), cA, voffA); PG8_STAGE(PG8_SA(0, 1), cA + hstepA, voffA);
        if (wr == 1) PG8_BAR;
        PG8_WAIT_V(2); PG8_BAR;
        PG8_STAGE(PG8_SB(1, 0), cB + kstep, voffB); PG8_STAGE(PG8_SA(1, 0), cA + kstep, voffA); PG8_STAGE(PG8_SB(1, 1), cB + hstepB + kstep, voffB);
        PG8_WAIT_V(6); PG8_BAR;
    } else {
        PG8_STAGE(PG8_SB(0, 0), cB, voffB); PG8_STAGE(PG8_SA(0, 0), cA, voffA); PG8_STAGE(PG8_SB(0, 1), cB + hstepB, voffB); PG8_STAGE(PG8_SA(0, 1), cA + hstepA, voffA);
        if (wr == 1) PG8_BAR;
        PG8_WAIT_V(4); PG8_BAR;
        PG8_STAGE(PG8_SB(1, 0), cB + kstep, voffB); PG8_STAGE(PG8_SA(1, 0), cA + kstep, voffA); PG8_STAGE(PG8_SB(1, 1), cB + hstepB + kstep, voffB);
        PG8_WAIT_V(6); PG8_BAR;
    }
    for (;;) {
        const bool has_next = S.next(ui + 1, nxt);
        const char* nA = has_next ? nxt.a : cA; const char* nB = has_next ? nxt.b : cB;
        for (int t = 0; t < nt; t += 2) {
            const bool last = (t == nt - 2);
            const char* a1 = cA + (size_t)(t + 1) * kstep;
            const char* a2 = last ? nA : cA + (size_t)(t + 2) * kstep; const char* b2 = last ? nB : cB + (size_t)(t + 2) * kstep;
            const char* a3 = a2 + kstep; const char* b3 = b2 + kstep;
            if (last && has_next) S.a_ready(nxt);
            if constexpr (SP2) {
            PG8_LDB(B0, 0, 0); PG8_LDB(B1, 0, 1); PG8_SCHED; PG8_LDA(At, 0, 0); PG8_STAGE(PG8_SA(1, 1), a1 + hstepA, voffA);
            PG8_WAIT_V(8); PG8_WAIT_L(0); PG8_BAR; PG8_MMA(0, 0, At, B0); PG8_MMA(0, 1, At, B1); PG8_BAR; PG8_SCHED;
            PG8_LDA(At, 0, 1); PG8_STAGE(PG8_SB(0, 0), b2, voffB); PG8_STAGE(PG8_SB(0, 1), b2 + hstepB, voffB); PG8_STAGE(PG8_SA(0, 0), a2, voffA);
            PG8_WAIT_V(8); PG8_WAIT_L(0); PG8_BAR; PG8_MMA(1, 0, At, B0); PG8_MMA(1, 1, At, B1); PG8_BAR; PG8_SCHED;
            PG8_LDB(B0, 1, 0); PG8_LDB(B1, 1, 1); PG8_SCHED; PG8_LDA(At, 1, 0); PG8_STAGE(PG8_SA(0, 1), a2 + hstepA, voffA);
            PG8_WAIT_V(8); PG8_WAIT_L(0); PG8_BAR; PG8_MMA(0, 0, At, B0); PG8_MMA(0, 1, At, B1); PG8_BAR; PG8_SCHED;
            PG8_LDA(At, 1, 1); PG8_STAGE(PG8_SB(1, 0), b3, voffB); PG8_STAGE(PG8_SB(1, 1), b3 + hstepB, voffB); PG8_STAGE(PG8_SA(1, 0), a3, voffA);
            PG8_WAIT_V(8); PG8_WAIT_L(0); PG8_BAR; PG8_MMA(1, 0, At, B0); PG8_MMA(1, 1, At, B1); PG8_BAR; PG8_SCHED;
            } else {
            PG8_LDB(B0, 0, 0); PG8_SCHED; PG8_LDA(At, 0, 0); PG8_STAGE(PG8_SA(1, 1), a1 + hstepA, voffA);
            PG8_WAIT_L(8); PG8_BAR; PG8_WAIT_L(0); PG8_MMA(0, 0, At, B0); PG8_BAR; PG8_SCHED;
            PG8_LDB(B1, 0, 1); PG8_STAGE(PG8_SB(0, 0), b2, voffB);
            PG8_BAR; PG8_WAIT_L(0); PG8_MMA(0, 1, At, B1); PG8_BAR;
            PG8_LDA(At, 0, 1); PG8_STAGE(PG8_SA(0, 0), a2, voffA);
            PG8_BAR; PG8_WAIT_L(0); PG8_MMA(1, 0, At, B0); PG8_BAR; PG8_SCHED;
            PG8_STAGE(PG8_SB(0, 1), b2 + hstepB, voffB);
            PG8_WAIT_V(6); PG8_BAR; PG8_MMA(1, 1, At, B1); PG8_BAR;
            PG8_LDB(B0, 1, 0); PG8_SCHED; PG8_LDA(At, 1, 0); PG8_STAGE(PG8_SA(0, 1), a2 + hstepA, voffA);
            PG8_WAIT_L(8); PG8_BAR; PG8_WAIT_L(0); PG8_MMA(0, 0, At, B0); PG8_BAR; PG8_SCHED;
            PG8_LDB(B1, 1, 1); PG8_STAGE(PG8_SB(1, 0), b3, voffB);
            PG8_BAR; PG8_WAIT_L(0); PG8_MMA(0, 1, At, B1); PG8_BAR;
            PG8_LDA(At, 1, 1); PG8_STAGE(PG8_SA(1, 0), a3, voffA);
            PG8_BAR; PG8_WAIT_L(0); PG8_MMA(1, 0, At, B0); PG8_BAR; PG8_SCHED;
            PG8_STAGE(PG8_SB(1, 1), b3 + hstepB, voffB);
            PG8_WAIT_V(6); PG8_BAR; PG8_MMA(1, 1, At, B1); PG8_BAR;
            }
        }
        if constexpr (ALIGN_EPI) { if (wr == 0) PG8_BAR; }
        if constexpr (!Epi::AFTER_DRAIN) { E(acc, cur, wr, wc, fr, fq); S.done(cur); }
        if (!has_next) break;
#pragma unroll
        for (int a = 0; a < 2; ++a)
#pragma unroll
            for (int b = 0; b < 2; ++b)
#pragma unroll
                for (int m = 0; m < 4; ++m)
#pragma unroll
                    for (int n = 0; n < 2; ++n) acc[a][b][m][n] = (f32x4){0.f, 0.f, 0.f, 0.f};
        cur = nxt; cA = nA; cB = nB; ++ui;
        if constexpr (ALIGN_EPI) { if (wr == 1) PG8_BAR; }
    }
    PG8_WAIT_V(0);
    if constexpr (!ALIGN_EPI) { if (wr == 0) PG8_BAR; }
    PG8_BAR;
    if constexpr (Epi::AFTER_DRAIN) { E.fused(acc, cur, wr, wc, fr, fq, lds, wid, lane); S.done(cur); }
#undef PG8_SA
#undef PG8_SB
#undef PG8_STAGE
#undef PG8_LDA
#undef PG8_LDB
#undef PG8_MMA
#undef PG8_WAIT_V
#undef PG8_WAIT_L
#undef PG8_BAR
#undef PG8_SCHED
}
}
#define GAS __attribute__((address_space(1)))
#define LAS __attribute__((address_space(3)))
typedef unsigned short bf16;
typedef unsigned v4u __attribute__((ext_vector_type(4)));
typedef unsigned v2u __attribute__((ext_vector_type(2)));
typedef float f32x4 __attribute__((ext_vector_type(4)));
typedef float f32x2 __attribute__((ext_vector_type(2)));
typedef GAS unsigned gu32;
#define RLX_AGENT __ATOMIC_RELAXED, __HIP_MEMORY_SCOPE_AGENT
#define LDS_WAIT() asm volatile("s_waitcnt lgkmcnt(0)" ::: "memory")
#define VM_WAIT() asm volatile("s_waitcnt vmcnt(0)" ::: "memory")
__device__ __forceinline__ unsigned f2bf(float f) { unsigned u = __builtin_bit_cast(unsigned, f); return (u + 0x7fffu + ((u >> 16) & 1u)) >> 16; }
__device__ __forceinline__ unsigned pk2(float lo, float hi) { return f2bf(lo) | (f2bf(hi) << 16); }
__device__ __forceinline__ float bflo(unsigned w) { return __uint_as_float(w << 16); }
__device__ __forceinline__ float bfhi(unsigned w) { return __uint_as_float(w & 0xffff0000u); }
__device__ __forceinline__ float bf2f(bf16 b) { return __uint_as_float(((unsigned)b) << 16); }

#define XB_TMO      128
#define XB_XCNT(j)  (256  + 64 * (j))
#define XB_XSUB(j)  (1280 + 64 * (j))
#define XB_XGEN(j)  (2304 + 64 * (j))
#define XB_TOP      3328
#define XB_TOPGEN   3392
#define XCD_BAR_WORDS 3456
#define XB_SPIN_CAP (1u << 22)

__device__ __forceinline__ unsigned xb_ld(unsigned* p)              { return __hip_atomic_load(p, __ATOMIC_RELAXED, __HIP_MEMORY_SCOPE_AGENT); }
__device__ __forceinline__ unsigned xb_add(unsigned* p, unsigned v) { return __hip_atomic_fetch_add(p, v, __ATOMIC_RELAXED, __HIP_MEMORY_SCOPE_AGENT); }
__device__ __forceinline__ unsigned xb_xcc_id() { return (unsigned)__builtin_amdgcn_s_getreg((3 << 11) | 20) & 0xFu; }
#define XB_SPIN(cond, bar) do { unsigned _sp = 0; while (cond) { __builtin_amdgcn_s_sleep(1); \
    if ((++_sp & 255u) == 0u) { if (xb_ld(&(bar)[XB_TMO])) break; if (_sp > XB_SPIN_CAP) { atomicAdd(&(bar)[XB_TMO], 1u); break; } } } } while (0)

struct XcdBarrier { unsigned* bar; unsigned x; volatile LAS unsigned* st; };
__device__ __forceinline__ XcdBarrier xcd_barrier_post(unsigned* bar, volatile LAS unsigned* st) {
    XcdBarrier b; b.bar = bar; b.x = xb_xcc_id(); b.st = st;
    if (threadIdx.x == 0) (void)xb_add(&bar[XB_XCNT(b.x)], 1u);
    return b;
}
__device__ __forceinline__ void xcd_barrier_complete(unsigned* bar, unsigned x, unsigned& nloc, unsigned& nx) {
    const unsigned G = gridDim.x * gridDim.y * gridDim.z;
    unsigned sum, cnt, mine, sp = 0u;
    for (;;) {
        sum = 0u; cnt = 0u; mine = 0u;
#pragma unroll
        for (unsigned j = 0; j < 16; ++j) { const unsigned c = xb_ld(&bar[XB_XCNT(j)]); sum += c; cnt += (c > 0u) ? 1u : 0u; mine = (j == x) ? c : mine; }
        if (sum == G) break;
        __builtin_amdgcn_s_sleep(1);
        if ((++sp & 255u) == 0u) { if (xb_ld(&bar[XB_TMO])) break; if (sp > XB_SPIN_CAP) { atomicAdd(&bar[XB_TMO], 1u); break; } }
    }
    nloc = mine > 0u ? mine : 1u; nx = cnt > 0u ? cnt : 1u;
}
__device__ __forceinline__ void xcd_barrier(const XcdBarrier& b) {
    asm volatile("s_waitcnt vmcnt(0)" ::: "memory");
    __syncthreads();
    if (threadIdx.x == 0) {
        unsigned* bar = b.bar;
        __builtin_amdgcn_s_waitcnt(0);
        unsigned nloc = b.st[0], nx = b.st[1];
        if (nloc == 0u) { xcd_barrier_complete(bar, b.x, nloc, nx); b.st[0] = nloc; b.st[1] = nx; }
        const unsigned old = xb_add(&bar[XB_XSUB(b.x)], 1u);
        const unsigned gen = old / nloc;
        if (old + 1u == (gen + 1u) * nloc) {
            __builtin_amdgcn_fence(__ATOMIC_RELEASE, "agent");
            asm volatile("s_waitcnt vmcnt(0)" ::: "memory");
            const unsigned og = xb_add(&bar[XB_TOP], 1u);
            const unsigned tg = og / nx;
            if (og + 1u == (tg + 1u) * nx) xb_add(&bar[XB_TOPGEN], 1u);
            else XB_SPIN(xb_ld(&bar[XB_TOPGEN]) == tg, bar);
            __builtin_amdgcn_fence(__ATOMIC_ACQUIRE, "agent");
            xb_add(&bar[XB_XGEN(b.x)], 1u);
            asm volatile("s_waitcnt vmcnt(0)" ::: "memory");
        } else {
            XB_SPIN(xb_ld(&bar[XB_XGEN(b.x)]) == gen, bar);
            __builtin_amdgcn_fence(__ATOMIC_ACQUIRE, "agent");
            asm volatile("s_waitcnt vmcnt(0)" ::: "memory");
        }
    }
    __syncthreads();
}

struct Frame {
    LAS unsigned char* lds;
    volatile LAS unsigned* MISC;
    gu32* ctl;
    int tid, lane, wave;
    int vcu, G;
    unsigned char* ws;
    float* out;
};
__device__ __forceinline__ float wave_sum(float v) {
#pragma unroll
    for (int o = 1; o < 64; o <<= 1) v += __shfl_xor(v, o);
    return v;
}
__device__ __forceinline__ int win_dest_row(int n) {
    if (n >= 2048) return n;
    const int n256 = n & 255, base = n - n256, hl = n256 >> 7, e = n256 & 127, bj = e >> 6;
    return base + 128 * bj + hl * 64 + (e & 63);
}
template <bool PERMUTE>
__device__ __forceinline__ void p0_transpose_item(const float* W, int K, int N, bf16* WT, int row_off, LAS float* scr, int item, int lane) {
    const int nblk = N / 32, kb = item / nblk, nb = item % nblk, k0 = 64 * kb, n0 = 32 * nb;
#pragma unroll 8
    for (int i = 0; i < 32; ++i) { const int kk = 2 * i + (lane >> 5); scr[kk * 33 + (lane & 31)] = W[(size_t)(k0 + kk) * N + n0 + (lane & 31)]; }
    LDS_WAIT(); asm volatile("" ::: "memory");
    const int c = lane & 7;
#pragma unroll
    for (int j = 0; j < 4; ++j) { const int n = (lane >> 3) + 8 * j; const LAS float* s = scr + (8 * c) * 33 + n;
        v4u o; o.x = pk2(s[0 * 33], s[1 * 33]); o.y = pk2(s[2 * 33], s[3 * 33]); o.z = pk2(s[4 * 33], s[5 * 33]); o.w = pk2(s[6 * 33], s[7 * 33]);
        const int dr = row_off + (PERMUTE ? win_dest_row(n0 + n) : (n0 + n));
        *(GAS v4u*)(WT + (size_t)dr * K + k0 + 8 * c) = o; }
    LDS_WAIT(); asm volatile("" ::: "memory");
}
struct RopeTab { double inv2pi[64]; };
__device__ __forceinline__ void p0a_prologue(Frame& F, const float* I_c, const float* I_w_ada, const float* I_b_ada, const float* I_w_in, const float* I_w_qm, const float* I_w_km, const float* I_w_vm, const float* I_w_if,
                                             const float* I_w_pa, const float* I_w_pm, const float* I_w_out, const int* I_pos, const double* inv2pi, int bid) {
    const int gtid = F.vcu * 512 + F.tid, NT = F.G * 512;
    {
        LAS float* sc = (LAS float*)(F.lds + RING_OFF);
        LAS float* red = (LAS float*)(F.lds + RING_OFF + 32768);
        float* ada = (float*)(F.ws + WS_ADA);
        if ((int)bid < 192) {
            for (int i = F.tid; i < 8192; i += 512) { const float v = I_c[i]; sc[i] = v / (1.0f + expf(-v)); }
            __syncthreads();
            for (int cb = bid; cb < 192; cb += F.G) {
                const int col = F.tid & 15, ks = F.tid >> 4;
                float a[8];
#pragma unroll
                for (int b = 0; b < 8; ++b) a[b] = 0.f;
                for (int kk = 0; kk < 32; ++kk) { const int k = ks * 32 + kk; const float w = I_w_ada[(size_t)k * 3072 + cb * 16 + col];
#pragma unroll
                    for (int b = 0; b < 8; ++b) a[b] += sc[b * 1024 + k] * w; }
#pragma unroll
                for (int b = 0; b < 8; ++b) red[(ks * 16 + col) * 8 + b] = a[b];
                __syncthreads();
                if (F.tid < 128) { const int c2 = F.tid & 15, b = F.tid >> 4; float s = 0.f; for (int k2 = 0; k2 < 32; ++k2) s += red[(k2 * 16 + c2) * 8 + b]; ada[b * 3072 + cb * 16 + c2] = s + I_b_ada[cb * 16 + c2]; }
                __syncthreads();
            }
        }
        __syncthreads();
    }
    {
        LAS float* scr = (LAS float*)(F.lds + RING_OFF + F.wave * 16384);
        const int gw = F.vcu * NWAVES + F.wave, NGW = F.G * NWAVES;
        constexpr int I_IN = (1024 / 64) * (8192 / 32), I_PA = (512 / 64) * (1024 / 32), I_PM = (1024 / 64) * (1024 / 32), I_OUT = I_PM, I_H = (256 / 64) * (256 / 32);
        constexpr int NITEMS = I_IN + I_PA + I_PM + I_OUT + 12 * I_H;
        bf16* WIN = (bf16*)(F.ws + WS_WIN); bf16* WPA = (bf16*)(F.ws + WS_WPA); bf16* WPM = (bf16*)(F.ws + WS_WPM); bf16* WOUT = (bf16*)(F.ws + WS_WOUT); bf16* WQKV = (bf16*)(F.ws + WS_WQKV);
        for (int it = gw; it < NITEMS; it += NGW) {
            int r = it;
            if (r < I_IN) { p0_transpose_item<true>(I_w_in, 1024, 8192, WIN, 0, scr, r, F.lane); continue; } r -= I_IN;
            if (r < I_PA) { p0_transpose_item<false>(I_w_pa, 512, 1024, WPA, 0, scr, r, F.lane); continue; } r -= I_PA;
            if (r < I_PM) { p0_transpose_item<false>(I_w_pm, 1024, 1024, WPM, 0, scr, r, F.lane); continue; } r -= I_PM;
            if (r < I_OUT) { p0_transpose_item<false>(I_w_out, 1024, 1024, WOUT, 0, scr, r, F.lane); continue; } r -= I_OUT;
            const int wh = r / I_H, ri = r % I_H, which = wh >> 2, head = wh & 3;
            const float* W = (which == 0 ? I_w_qm : (which == 1 ? I_w_km : I_w_vm)) + (size_t)head * 65536;
            p0_transpose_item<false>(W, 256, 256, WQKV, wh * 256, scr, ri, F.lane);
        }
    }
    {
        float* rope = (float*)(F.ws + WS_ROPE);
        for (int i = gtid; i < TT * 64; i += NT) { const int t = i >> 6, e = i & 63; double a = (double)I_pos[t] * inv2pi[e]; a -= __builtin_rint(a);
            const float ang = (float)a * 6.283185307179586f; f32x2 cs; cs.x = cosf(ang); cs.y = sinf(ang); *(f32x2*)(rope + (size_t)i * 2) = cs; }
    }
    {
        float* gwp = (float*)(F.ws + WS_GW);
        for (int i = gtid; i < 16384; i += NT) { const int which = i >> 13, c = (i >> 3) & 1023, j = i & 7, h = c >> 8;
            float s = 0.f;
            if (which == 0) { const float* wq = I_w_qm + (size_t)c * 256; const float* wk = I_w_km + (size_t)c * 256; float sq = 0.f, sk = 0.f;
                for (int e = 0; e < 256; ++e) { sq += wq[e] * I_w_if[(size_t)(h * 256 + e) * 8 + j]; sk += wk[e] * I_w_if[(size_t)(1024 + h * 256 + e) * 8 + j]; }
                s = sq + 0.0625f * sk; }
            else { const float* wv = I_w_vm + (size_t)c * 256; for (int e = 0; e < 256; ++e) s += wv[e] * I_w_if[(size_t)(2048 + h * 256 + e) * 8 + j]; }
            gwp[i] = s; }
    }
}
__device__ __forceinline__ bf16* h_row_ptr(Frame& F, int R) { return (bf16*)((unsigned char*)F.out + (size_t)(R / TH) * (64 * MiB)) + (size_t)(R % TH) * DM; }
__device__ __forceinline__ void p0b_lnmod(Frame& F, const float* x) {
    const int gw = F.vcu * NWAVES + F.wave, NGW = F.G * NWAVES;
    const float* ada = (const float*)(F.ws + WS_ADA);
    for (int R = gw; R < TT; R += NGW) {
        const GAS f32x4* xr = (const GAS f32x4*)(x + (size_t)R * DM) + F.lane;
        f32x4 v[4]; float s = 0.f;
#pragma unroll
        for (int j = 0; j < 4; ++j) { v[j] = xr[64 * j]; s += (v[j].x + v[j].y) + (v[j].z + v[j].w); }
        const float mean = wave_sum(s) * (1.f / DM); float s2 = 0.f;
#pragma unroll
        for (int j = 0; j < 4; ++j) { v[j] = v[j] - mean; s2 += (v[j].x * v[j].x + v[j].y * v[j].y) + (v[j].z * v[j].z + v[j].w * v[j].w); }
        const float rstd = 1.f / sqrtf(wave_sum(s2) * (1.f / DM) + LN_EPS);
        const int b = R >> 12; const f32x4* sh = (const f32x4*)(ada + (size_t)b * 3072) + F.lane; const f32x4* sc = (const f32x4*)(ada + (size_t)b * 3072 + 1024) + F.lane;
        GAS unsigned long long* o8 = (GAS unsigned long long*)h_row_ptr(F, R) + F.lane;
#pragma unroll
        for (int j = 0; j < 4; ++j) { const f32x4 a = sh[64 * j], m = sc[64 * j]; const f32x4 y = v[j] * rstd * (m + 1.0f) + a;
            o8[64 * j] = (unsigned long long)pk2(y.x, y.y) | ((unsigned long long)pk2(y.z, y.w) << 32); }
    }
}
__device__ __forceinline__ float logsigmoidf(float x) { return fminf(x, 0.f) - log1pf(expf(-fabsf(x))); }
__device__ __forceinline__ void p2a_conv(Frame& F, int half, const float* conv_w, const float* conv_b, const float* b_if, int bid) {
    const bf16* XM = (const bf16*)(F.ws + WS_XM); bf16* XC = (bf16*)(F.ws + WS_XC);
    float* gli = (float*)(F.ws + WS_GATES); float* glf = gli + (size_t)TT * 4;
    const float* gwp = (const float*)(F.ws + WS_GW);
    LAS float* red = (LAS float*)(F.lds + RING_OFF);
    const int cg = F.tid & 255, grp = F.tid >> 8, c0 = 4 * cg;
    float cw[4][4], cb[4], ga[4][8], gb[4][8];
#pragma unroll
    for (int j = 0; j < 4; ++j) { const f32x4 w = *(const f32x4*)(conv_w + j * 1024 + c0); cw[j][0] = w.x; cw[j][1] = w.y; cw[j][2] = w.z; cw[j][3] = w.w; }
    { const f32x4 w = *(const f32x4*)(conv_b + c0); cb[0] = w.x; cb[1] = w.y; cb[2] = w.z; cb[3] = w.w; }
#pragma unroll
    for (int ch = 0; ch < 4; ++ch)
#pragma unroll
        for (int j = 0; j < 8; ++j) { ga[ch][j] = gwp[(c0 + ch) * 8 + j]; gb[ch][j] = gwp[8192 + (c0 + ch) * 8 + j]; }
    for (int item = bid; item < TH / 64; item += F.G) {
        const int r0 = item * 64 + grp * 32; const int s0 = (half * TH + r0) & (SEQ - 1);
        float h1[4], h2[4], h3[4];
        if (s0 == 0) {
#pragma unroll
            for (int ch = 0; ch < 4; ++ch) { h1[ch] = 0.f; h2[ch] = 0.f; h3[ch] = 0.f; }
        } else {
            const v2u a1 = *(const v2u*)(XM + (size_t)(r0 - 1) * 1024 + c0), a2 = *(const v2u*)(XM + (size_t)(r0 - 2) * 1024 + c0), a3 = *(const v2u*)(XM + (size_t)(r0 - 3) * 1024 + c0);
            h1[0] = bflo(a1.x); h1[1] = bfhi(a1.x); h1[2] = bflo(a1.y); h1[3] = bfhi(a1.y);
            h2[0] = bflo(a2.x); h2[1] = bfhi(a2.x); h2[2] = bflo(a2.y); h2[3] = bfhi(a2.y);
            h3[0] = bflo(a3.x); h3[1] = bfhi(a3.x); h3[2] = bflo(a3.y); h3[3] = bfhi(a3.y);
        }
        for (int bt = 0; bt < 4; ++bt) {
            float acc[64];
#pragma unroll
            for (int i = 0; i < 64; ++i) acc[i] = 0.f;
#pragma unroll
            for (int tk = 0; tk < 8; ++tk) {
                const int r = r0 + bt * 8 + tk;
                const v2u xw = *(const v2u*)(XM + (size_t)r * 1024 + c0);
                float xv[4] = {bflo(xw.x), bfhi(xw.x), bflo(xw.y), bfhi(xw.y)}, xc[4];
#pragma unroll
                for (int ch = 0; ch < 4; ++ch) { const float pre = cb[ch] + cw[0][ch] * h3[ch] + cw[1][ch] * h2[ch] + cw[2][ch] * h1[ch] + cw[3][ch] * xv[ch];
                    xc[ch] = pre / (1.0f + __expf(-pre)); h3[ch] = h2[ch]; h2[ch] = h1[ch]; h1[ch] = xv[ch]; }
                v2u ow; ow.x = pk2(xc[0], xc[1]); ow.y = pk2(xc[2], xc[3]);
                *(v2u*)(XC + (size_t)r * 1024 + c0) = ow;
#pragma unroll
                for (int j = 0; j < 8; ++j) { float s = 0.f;
#pragma unroll
                    for (int ch = 0; ch < 4; ++ch) s += xc[ch] * ga[ch][j] + xv[ch] * gb[ch][j];
                    acc[tk * 8 + j] = s; }
            }
#define RS_STEP(H) { const bool up = (F.lane & (H)) != 0; _Pragma("unroll") for (int i = 0; i < (H); ++i) { const float a = acc[i], b = acc[i + (H)]; const float keep = up ? b : a, send = up ? a : b; acc[i] = keep + __shfl_xor(send, (H)); } }
            RS_STEP(32) RS_STEP(16) RS_STEP(8) RS_STEP(4) RS_STEP(2) RS_STEP(1)
#undef RS_STEP
            red[F.wave * 64 + F.lane] = acc[0];
            __syncthreads();
            if ((F.wave & 3) == 0) { const int wb = F.wave * 64 + F.lane; const float v = (red[wb] + red[wb + 64]) + (red[wb + 128] + red[wb + 192]);
                const int tk = F.lane >> 3, j = F.lane & 7; const size_t R = (size_t)half * TH + r0 + bt * 8 + tk; const float g = v + b_if[j];
                if (j < 4) gli[R * 4 + j] = g; else glf[R * 4 + (j - 4)] = logsigmoidf(g); }
            __syncthreads();
        }
    }
}
__device__ __forceinline__ void p3_attention_simple(Frame& F, int half) {
    const bf16* QA = (const bf16*)(F.ws + WS_QA); const bf16* KA = (const bf16*)(F.ws + WS_KA); const bf16* VA = (const bf16*)(F.ws + WS_VA); const bf16* ZA = (const bf16*)(F.ws + WS_ZA);
    bf16* ATG = (bf16*)(F.ws + WS_OG);
    const int gw = F.vcu * NWAVES + F.wave, NGW = F.G * NWAVES, d = 2 * F.lane;
    for (int item = gw; item < TH * 4; item += NGW) {
        const int r = item >> 2, h = item & 3, s = (half * TH + r) & (SEQ - 1);
        float m = -1e30f, l = 0.f, o0 = 0.f, o1 = 0.f;
        for (int g = 0; g < 3; ++g) { const int dil = 1 << (2 * g);
            const unsigned qw = *(const unsigned*)(QA + (size_t)r * 1536 + (g * 4 + h) * 128 + d); const float q0 = bflo(qw), q1 = bfhi(qw);
            int nk = s / dil; if (nk > 128) nk = 128;
            for (int j = 0; j <= nk; ++j) { const size_t rk = (size_t)(r - j * dil);
                const unsigned kw = *(const unsigned*)(KA + rk * 512 + h * 128 + d); const unsigned vw = *(const unsigned*)(VA + rk * 512 + h * 128 + d);
                const float dot = wave_sum(q0 * bflo(kw) + q1 * bfhi(kw)) * ATT_SCALE;
                const float mn = fmaxf(m, dot), al = __expf(m - mn), p = __expf(dot - mn);
                l = l * al + p; o0 = o0 * al + p * bflo(vw); o1 = o1 * al + p * bfhi(vw); m = mn; } }
        const unsigned zw = *(const unsigned*)(ZA + (size_t)r * 512 + h * 128 + d); const float il = 1.0f / l;
        *(unsigned*)(ATG + (size_t)r * 512 + h * 128 + d) = pk2(o0 * il * bflo(zw), o1 * il * bfhi(zw));
    }
}
__device__ __forceinline__ void p3_chain_simple(Frame& F, int half, int bid) {
    const bf16* QM = (const bf16*)(F.ws + WS_QM); const bf16* KM = (const bf16*)(F.ws + WS_KM); const bf16* VM = (const bf16*)(F.ws + WS_VM); const bf16* OM = (const bf16*)(F.ws + WS_OM);
    bf16* Y = (bf16*)(F.ws + WS_Y);
    const float* gli = (const float*)(F.ws + WS_GATES); const float* glf = gli + (size_t)TT * 4;
    const int dd = F.tid >> 4, ec = F.tid & 15;
    for (int ch = bid; ch < 128; ch += F.G) {
        const int bl = ch >> 5, h = (ch >> 3) & 3, ds = ch & 7, c = h * 256 + ds * 32 + dd, eb = h * 256 + ec * 16;
        float C[16], n[16], m = 0.f;
#pragma unroll
        for (int i = 0; i < 16; ++i) { C[i] = 0.f; n[i] = 0.f; }
        for (int t = 0; t < SEQ; ++t) { const size_t r = (size_t)bl * SEQ + t, R = (size_t)half * TH + r;
            const float li = gli[R * 4 + h], lf = glf[R * 4 + h];
            const v4u k0 = *(const v4u*)(KM + r * 1024 + eb), k1 = *(const v4u*)(KM + r * 1024 + eb + 8), q0 = *(const v4u*)(QM + r * 1024 + eb), q1 = *(const v4u*)(QM + r * 1024 + eb + 8);
            const float v = bf2f(VM[r * 1024 + c]);
            const float mn = fmaxf(lf + m, li), fp = __expf(lf + m - mn), ip = __expf(li - mn);
            float kk[16] = {bflo(k0.x), bfhi(k0.x), bflo(k0.y), bfhi(k0.y), bflo(k0.z), bfhi(k0.z), bflo(k0.w), bfhi(k0.w), bflo(k1.x), bfhi(k1.x), bflo(k1.y), bfhi(k1.y), bflo(k1.z), bfhi(k1.z), bflo(k1.w), bfhi(k1.w)};
            float qq[16] = {bflo(q0.x), bfhi(q0.x), bflo(q0.y), bfhi(q0.y), bflo(q0.z), bfhi(q0.z), bflo(q0.w), bfhi(q0.w), bflo(q1.x), bfhi(q1.x), bflo(q1.y), bfhi(q1.y), bflo(q1.z), bfhi(q1.z), bflo(q1.w), bfhi(q1.w)};
            float num = 0.f, den = 0.f; const float iv = ip * v;
#pragma unroll
            for (int i = 0; i < 16; ++i) { C[i] = fp * C[i] + iv * kk[i]; n[i] = fp * n[i] + ip * kk[i]; num += C[i] * qq[i]; den += n[i] * qq[i]; }
#pragma unroll
            for (int o = 1; o < 16; o <<= 1) { num += __shfl_xor(num, o); den += __shfl_xor(den, o); }
            const float hv = num / fmaxf(fabsf(den), __expf(-mn)); m = mn;
            if (ec == 0) Y[r * 1024 + c] = (bf16)f2bf(bf2f(OM[r * 1024 + c]) * hv);
        }
    }
}
template <bool MERGE>
__device__ __forceinline__ void p4a_finalize(Frame& F, int half, const float* mh_norm_w, const float* skip_m) {
    const bf16* Y = (const bf16*)(F.ws + WS_Y); const bf16* XC = (const bf16*)(F.ws + WS_XC); const bf16* ZM = (const bf16*)(F.ws + WS_ZM); bf16* HMG = (bf16*)(F.ws + WS_HMG);
    const bf16* OG = (const bf16*)(F.ws + WS_OG); const bf16* ZA = (const bf16*)(F.ws + WS_ZA); const float* LSE = (const float*)(F.ws + WS_LSE); bf16* ATG = (bf16*)(F.ws + WS_ATG);
    const int gw = F.vcu * NWAVES + F.wave, NGW = F.G * NWAVES, c16 = 16 * F.lane, c8 = 8 * F.lane, hd = F.lane >> 4;
    float nw[16], sk[16];
#pragma unroll
    for (int i = 0; i < 16; ++i) { nw[i] = mh_norm_w[c16 + i]; sk[i] = skip_m[c16 + i]; }
    for (int r = gw; r < TH; r += NGW) {
        { const v4u y0 = *(const v4u*)(Y + (size_t)r * 1024 + c16), y1 = *(const v4u*)(Y + (size_t)r * 1024 + c16 + 8);
          float y[16] = {bflo(y0.x), bfhi(y0.x), bflo(y0.y), bfhi(y0.y), bflo(y0.z), bfhi(y0.z), bflo(y0.w), bfhi(y0.w), bflo(y1.x), bfhi(y1.x), bflo(y1.y), bfhi(y1.y), bflo(y1.z), bfhi(y1.z), bflo(y1.w), bfhi(y1.w)};
          float s = 0.f;
#pragma unroll
          for (int i = 0; i < 16; ++i) s += y[i];
#pragma unroll
          for (int o = 1; o < 16; o <<= 1) s += __shfl_xor(s, o);
          const float mu = s * (1.f / 256.f); float q = 0.f;
#pragma unroll
          for (int i = 0; i < 16; ++i) { y[i] -= mu; q += y[i] * y[i]; }
#pragma unroll
          for (int o = 1; o < 16; o <<= 1) q += __shfl_xor(q, o);
          const float rstd = 1.f / sqrtf(q * (1.f / 256.f) + LN_EPS);
          const v4u x0 = *(const v4u*)(XC + (size_t)r * 1024 + c16), x1 = *(const v4u*)(XC + (size_t)r * 1024 + c16 + 8), z0 = *(const v4u*)(ZM + (size_t)r * 1024 + c16), z1 = *(const v4u*)(ZM + (size_t)r * 1024 + c16 + 8);
          const float xx[16] = {bflo(x0.x), bfhi(x0.x), bflo(x0.y), bfhi(x0.y), bflo(x0.z), bfhi(x0.z), bflo(x0.w), bfhi(x0.w), bflo(x1.x), bfhi(x1.x), bflo(x1.y), bfhi(x1.y), bflo(x1.z), bfhi(x1.z), bflo(x1.w), bfhi(x1.w)};
          const float zz[16] = {bflo(z0.x), bfhi(z0.x), bflo(z0.y), bfhi(z0.y), bflo(z0.z), bfhi(z0.z), bflo(z0.w), bfhi(z0.w), bflo(z1.x), bfhi(z1.x), bflo(z1.y), bfhi(z1.y), bflo(z1.z), bfhi(z1.z), bflo(z1.w), bfhi(z1.w)};
          float o[16];
#pragma unroll
          for (int i = 0; i < 16; ++i) o[i] = (y[i] * rstd * nw[i] + sk[i] * xx[i]) * zz[i];
          v4u w0, w1; w0.x = pk2(o[0], o[1]); w0.y = pk2(o[2], o[3]); w0.z = pk2(o[4], o[5]); w0.w = pk2(o[6], o[7]); w1.x = pk2(o[8], o[9]); w1.y = pk2(o[10], o[11]); w1.z = pk2(o[12], o[13]); w1.w = pk2(o[14], o[15]);
          *(v4u*)(HMG + (size_t)r * 1024 + c16) = w0; *(v4u*)(HMG + (size_t)r * 1024 + c16 + 8) = w1; }
        if constexpr (MERGE) {
            const float l0 = LSE[(size_t)r * 4 + hd], l1 = LSE[(size_t)(TH + r) * 4 + hd], l2 = LSE[(size_t)(2 * TH + r) * 4 + hd];
            const float mx = fmaxf(l0, fmaxf(l1, l2)); float w0 = __expf(l0 - mx), w1 = __expf(l1 - mx), w2 = __expf(l2 - mx); const float iw = 1.f / (w0 + w1 + w2); w0 *= iw; w1 *= iw; w2 *= iw;
            const v4u a = *(const v4u*)(OG + (size_t)r * 512 + c8), b = *(const v4u*)(OG + (size_t)(TH + r) * 512 + c8), c = *(const v4u*)(OG + (size_t)(2 * TH + r) * 512 + c8), z = *(const v4u*)(ZA + (size_t)r * 512 + c8);
            v4u o;
            o.x = pk2((w0 * bflo(a.x) + w1 * bflo(b.x) + w2 * bflo(c.x)) * bflo(z.x), (w0 * bfhi(a.x) + w1 * bfhi(b.x) + w2 * bfhi(c.x)) * bfhi(z.x));
            o.y = pk2((w0 * bflo(a.y) + w1 * bflo(b.y) + w2 * bflo(c.y)) * bflo(z.y), (w0 * bfhi(a.y) + w1 * bfhi(b.y) + w2 * bfhi(c.y)) * bfhi(z.y));
            o.z = pk2((w0 * bflo(a.z) + w1 * bflo(b.z) + w2 * bflo(c.z)) * bflo(z.z), (w0 * bfhi(a.z) + w1 * bfhi(b.z) + w2 * bfhi(c.z)) * bfhi(z.z));
            o.w = pk2((w0 * bflo(a.w) + w1 * bflo(b.w) + w2 * bflo(c.w)) * bflo(z.w), (w0 * bfhi(a.w) + w1 * bfhi(b.w) + w2 * bfhi(c.w)) * bfhi(z.w));
            *(v4u*)(ATG + (size_t)r * 512 + c8) = o;
        }
    }
}
__device__ __forceinline__ void p5b_ln(Frame& F, int half, const float* ln_g, const float* ln_b) {
    const int gw = F.vcu * NWAVES + F.wave, NGW = F.G * NWAVES;
    f32x4 g4[4], b4[4];
#pragma unroll
    for (int j = 0; j < 4; ++j) { g4[j] = ((const f32x4*)ln_g)[F.lane + 64 * j]; b4[j] = ((const f32x4*)ln_b)[F.lane + 64 * j]; }
    for (int r = gw; r < TH; r += NGW) {
        GAS f32x4* xr = (GAS f32x4*)(F.out + ((size_t)half * TH + r) * DM) + F.lane;
        f32x4 v[4]; float s = 0.f;
#pragma unroll
        for (int j = 0; j < 4; ++j) { v[j] = xr[64 * j]; s += (v[j].x + v[j].y) + (v[j].z + v[j].w); }
        const float mean = wave_sum(s) * (1.f / DM); float s2 = 0.f;
#pragma unroll
        for (int j = 0; j < 4; ++j) { v[j] = v[j] - mean; s2 += (v[j].x * v[j].x + v[j].y * v[j].y) + (v[j].z * v[j].z + v[j].w * v[j].w); }
        const float rstd = 1.f / sqrtf(wave_sum(s2) * (1.f / DM) + LN_EPS);
#pragma unroll
        for (int j = 0; j < 4; ++j) xr[64 * j] = v[j] * rstd * g4[j] + b4[j];
    }
}
#ifndef ONE_LAUNCH
#define ONE_LAUNCH 0
#endif
#ifndef ATT_SIMPLE
#define ATT_SIMPLE 1
#endif
#ifndef CHAIN_SIMPLE
#define CHAIN_SIMPLE 1
#endif
constexpr int NPH = 10;
struct Args { const void* in[20]; float* out; unsigned char* ws; RopeTab rt; int ph_lo, ph_hi, h_lo, h_hi, one_launch, pad; };
__global__ void __launch_bounds__(NWAVES * 64, 2) hyb_fwd(Args args) {
    extern __shared__ __attribute__((aligned(16))) unsigned char lds[];
    Frame F;
    F.lds = (LAS unsigned char*)lds;
    F.MISC = (volatile LAS unsigned*)(F.lds + MISC_OFF);
    F.tid = threadIdx.x; F.lane = F.tid & 63; F.wave = __builtin_amdgcn_readfirstlane(F.tid >> 6);
    F.G = gridDim.x; { const int bx = blockIdx.x; F.vcu = (F.G % 8 == 0) ? (bx % 8) * (F.G / 8) + bx / 8 : bx; }
    F.ws = args.ws; F.ctl = (gu32*)(args.ws + WS_CTL);
    F.out = args.out;
#define INF(k) ((const float*)args.in[k])
    for (int u = F.tid; u < (LDS_BYTES - LDSCTL_OFF) / 4; u += NWAVES * 64) ((LAS unsigned*)(F.lds + LDSCTL_OFF))[u] = 0u;
    __syncthreads();
    XcdBarrier bar; bar.bar = (unsigned*)(F.ctl + CW_BAR); bar.x = 0; bar.st = nullptr;
    if (args.one_launch) bar = xcd_barrier_post((unsigned*)(F.ctl + CW_BAR), F.MISC + 8);
#define GRID_BAR() do { if (args.one_launch) xcd_barrier(bar); } while (0)
    const int lo = args.ph_lo, hi = args.ph_hi;
#ifndef PHASE_MASK
#define PHASE_MASK 0x3ff
#endif
#define IN(k) (((PHASE_MASK >> (k)) & 1) && lo <= (k) && (k) < hi)
#define PHASE_BEGIN() do { int t_ = threadIdx.x, b_ = blockIdx.x; asm volatile("" : "+v"(t_)); asm volatile("" : "+s"(b_)); F.tid = t_; F.lane = t_ & 63; F.wave = __builtin_amdgcn_readfirstlane(t_ >> 6); bid = b_; \
        F.vcu = (F.G % 8 == 0) ? (b_ % 8) * (F.G / 8) + b_ / 8 : b_; } while (0)
    int bid = blockIdx.x;
    if (IN(0)) { PHASE_BEGIN(); p0a_prologue(F, INF(1), INF(3), INF(4), INF(5), INF(8), INF(9), INF(10), INF(11), INF(15), INF(16), INF(17), (const int*)args.in[2], args.rt.inv2pi, bid); GRID_BAR(); }
    if (IN(1)) { PHASE_BEGIN(); p0b_lnmod(F, INF(0)); GRID_BAR(); }
    for (int half = args.h_lo; half < args.h_hi; ++half) {
        if (IN(2)) { PHASE_BEGIN();
            pg8::Gemm g{1024, 1024, 1024}; pg8::PlainOrder S; S.init(TH / 256, INW / 256, F.G, bid);
            S.set((unsigned char*)F.out + (size_t)half * (64 * MiB), F.ws + WS_WIN, 1024, 1024);
            pg8::EpiProj E{F.ws, (const float*)(F.ws + WS_ROPE) + (size_t)half * TH * 128};
            pg8::gemm_phase<pg8::EpiProj, pg8::PlainOrder, true, true>(F.lds + RING_OFF, g, S, E, F.tid);
            GRID_BAR();
        }
        if (IN(3)) { PHASE_BEGIN(); p2a_conv(F, half, INF(6), INF(7), INF(12), bid); GRID_BAR(); }
        if (IN(4)) { PHASE_BEGIN();
            int kq_ = 256; asm volatile("" : "+s"(kq_)); pg8::Gemm g{1024, 256, kq_}; pg8::QkvOrder S; S.init(TH / 256, 12, F.G, bid);
            S.ws = (const char*)F.ws;
            pg8::EpiQkv E{F.ws};
            pg8::gemm_phase<pg8::EpiQkv, pg8::QkvOrder, true, true>(F.lds + RING_OFF, g, S, E, F.tid);
            GRID_BAR();
        }
        if (IN(5)) { PHASE_BEGIN();
#if CHAIN_SIMPLE
            p3_chain_simple(F, half, bid);
#endif
#if ATT_SIMPLE
            p3_attention_simple(F, half);
#endif
            GRID_BAR();
        }
        if (IN(6)) { PHASE_BEGIN(); p4a_finalize<!ATT_SIMPLE>(F, half, INF(13), INF(14)); GRID_BAR(); }
        if (IN(7)) { PHASE_BEGIN();
            bf16* MRG = (bf16*)(F.ws + WS_MRG);
            { pg8::Gemm g{512, 512, 512}; pg8::PlainOrder S; S.init(TH / 256, 4, F.G, bid); S.set(F.ws + (ATT_SIMPLE ? WS_OG : WS_ATG), F.ws + WS_WPA, 512, 512);
              pg8::EpiGate<0> E{(const bf16*)(F.ws + WS_GA), MRG}; pg8::gemm_phase<pg8::EpiGate<0>, pg8::PlainOrder, false, true>(F.lds + RING_OFF, g, S, E, F.tid); }
            PHASE_BEGIN();
            { pg8::Gemm g{1024, 1024, 1024}; pg8::PlainOrder S; S.init(TH / 256, 4, F.G, bid); S.set(F.ws + WS_HMG, F.ws + WS_WPM, 1024, 1024);
              pg8::EpiGate<1> E{(const bf16*)(F.ws + WS_GM), MRG}; pg8::gemm_phase<pg8::EpiGate<1>, pg8::PlainOrder, false, true>(F.lds + RING_OFF, g, S, E, F.tid); }
            GRID_BAR();
        }
        if (IN(8)) { PHASE_BEGIN();
            pg8::Gemm g{1024, 1024, 1024}; pg8::PlainOrder S; S.init(TH / 256, 4, F.G, bid); S.set(F.ws + WS_MRG, F.ws + WS_WOUT, 1024, 1024);
            pg8::EpiRes E{INF(0) + (size_t)half * TH * DM, F.out + (size_t)half * TH * DM, (const float*)(F.ws + WS_ADA) + 2048, half * TH, 1.189207115002721f};
            pg8::gemm_phase<pg8::EpiRes, pg8::PlainOrder, false, true>(F.lds + RING_OFF, g, S, E, F.tid);
            GRID_BAR();
        }
        if (IN(9)) { PHASE_BEGIN(); p5b_ln(F, half, INF(18), INF(19)); }
    }
#undef IN
#undef GRID_BAR
}

extern "C" void kernel_launch(void* const* d_in, const int* in_sizes, int n_in, void* d_out, int out_size, void* d_ws, size_t ws_size, hipStream_t stream) {
    static int grid = 0;
    if (grid == 0) {
        if (n_in != 20 || in_sizes[0] != TT * DM || out_size != TT * DM || ws_size < WS_END) { fprintf(stderr, "kernel_launch: unexpected shapes (n_in %d, in0 %d, out %d, ws %zu); nothing launched\n", n_in, n_in > 0 ? in_sizes[0] : -1, out_size, ws_size); grid = -1; return; }
        int dev = 0, cus = 0;
        if (hipGetDevice(&dev) != hipSuccess || hipDeviceGetAttribute(&cus, hipDeviceAttributeMultiprocessorCount, dev) != hipSuccess) { grid = -1; return; }
        if (hipFuncSetAttribute((const void*)hyb_fwd, hipFuncAttributeMaxDynamicSharedMemorySize, LDS_BYTES) != hipSuccess) { fprintf(stderr, "kernel_launch: hipFuncSetAttribute failed\n"); grid = -1; return; }
        int per_cu = 0;
        if (hipOccupancyMaxActiveBlocksPerMultiprocessor(&per_cu, (const void*)hyb_fwd, NWAVES * 64, LDS_BYTES) != hipSuccess || per_cu < 1) fprintf(stderr, "kernel_launch: occupancy query says %d\n", per_cu);
        (void)hipGetLastError();
        grid = cus;
    }
    if (grid < 0) return;
    if (hipMemsetAsync((char*)d_ws + WS_CTL, 0, CTL_ZERO_BYTES, stream) != hipSuccess) return;
    Args a; memset(&a, 0, sizeof(a));
    for (int i = 0; i < 20; ++i) a.in[i] = d_in[i];
    a.out = (float*)d_out; a.ws = (unsigned char*)d_ws;
    for (int e = 0; e < 64; ++e) a.rt.inv2pi[e] = pow(10000.0, -(double)e / 64.0) / 6.283185307179586476925286766559;
#if ONE_LAUNCH
    a.ph_lo = 0; a.ph_hi = NPH; a.h_lo = 0; a.h_hi = NHALF; a.one_launch = 1;
    hipLaunchKernelGGL(hyb_fwd, dim3(grid), dim3(NWAVES * 64), LDS_BYTES, stream, a);
#else
    a.one_launch = 0;
    for (int p = 0; p < 2; ++p) { a.ph_lo = p; a.ph_hi = p + 1; a.h_lo = 0; a.h_hi = 0; hipLaunchKernelGGL(hyb_fwd, dim3(grid), dim3(NWAVES * 64), LDS_BYTES, stream, a); }
    for (int h = 0; h < NHALF; ++h)
        for (int p = 2; p < NPH; ++p) { a.ph_lo = p; a.ph_hi = p + 1; a.h_lo = h; a.h_hi = h + 1; hipLaunchKernelGGL(hyb_fwd, dim3(grid), dim3(NWAVES * 64), LDS_BYTES, stream, a); }
#endif
    const hipError_t le = hipPeekAtLastError();
    if (le != hipSuccess) fprintf(stderr, "kernel_launch: launch failed: %s\n", hipGetErrorName(le));
}
```

```cpp
#define ATT_SIMPLE 0
#define CHAIN_SIMPLE 0
#define ONE_LAUNCH 1
#include <hip/hip_runtime.h>
#include <cstdio>
#include <cstdint>
#include <cstring>
#include <cmath>
constexpr int BATCH = 8, SEQ = 4096, DM = 1024, TT = BATCH * SEQ, NHALF = 2, TH = TT / NHALF, INW = 8192;
constexpr int MH = 4, MHD = 256, MCHUNK = 128;
constexpr float LN_EPS = 1e-5f;
constexpr float ATT_SCALE = 0.08838834764831845f;
constexpr int NWAVES = 8;
constexpr size_t MiB = 1u << 20;
constexpr size_t WS_CTL = 0, CTL_ZERO_BYTES = 1 * MiB;
constexpr size_t WS_ADA = 1 * MiB;
constexpr size_t WS_GW = 1 * MiB + 128 * 1024;
constexpr size_t WS_GATES = 2 * MiB;
constexpr size_t WS_LSE = 3 * MiB;
constexpr size_t WS_WIN = 4 * MiB, WS_WPA = 20 * MiB, WS_WPM = 21 * MiB, WS_WOUT = 23 * MiB, WS_WQKV = 25 * MiB;
constexpr size_t WS_ROPE = 27 * MiB;
constexpr size_t WS_QA = 44 * MiB, WS_KA = 92 * MiB, WS_VA = 108 * MiB, WS_ZA = 124 * MiB, WS_XM = 140 * MiB, WS_ZM = 172 * MiB, WS_OM = 204 * MiB, WS_GA = 236 * MiB, WS_GM = 268 * MiB;
constexpr size_t WS_XC = 300 * MiB, WS_QM = 332 * MiB, WS_KM = 364 * MiB, WS_VM = 396 * MiB, WS_OG = 428 * MiB, WS_END = 476 * MiB;
constexpr size_t WS_Y = WS_XM;
constexpr size_t WS_HMG = WS_QA;
constexpr size_t WS_ATG = WS_KA;
constexpr size_t WS_MRG = WS_QM;
constexpr int CW_TMO = 0, CW_CODE = 1;
constexpr int CW_BAR = 4096;
constexpr int CW_QUEUE = 16384;
constexpr int RING_OFF = 0, RING_BYTES = 131072;
constexpr int LDSCTL_OFF = RING_BYTES, MISC_OFF = LDSCTL_OFF + 320;
constexpr int LDS_BYTES = 147456;
static_assert(MISC_OFF + 128 <= LDS_BYTES, "LDS map");

namespace pg8 {
#define PG8_LAS __attribute__((address_space(3)))
typedef unsigned short bf16_t;
typedef short bf16x8 __attribute__((ext_vector_type(8)));
typedef float f32x4 __attribute__((ext_vector_type(4)));
typedef float f32x2 __attribute__((ext_vector_type(2)));
typedef unsigned u32x4 __attribute__((ext_vector_type(4)));
typedef unsigned u32x2 __attribute__((ext_vector_type(2)));
constexpr int BM = 256, BK = 64, HALF = 128, HTB = HALF * BK * 2  , STAGE_BYTES = 8 * HTB, NXCD = 8, WGM = 8;

__host__ __device__ __forceinline__ int lds_byte(int r, int c) { const int st = (r >> 4) * 2 + (c >> 5), rr = r & 15, cc = c & 31, ob = rr * 64 + cc * 2; return st * 1024 + (ob ^ (((ob >> 9) & 1) << 5)); }
__host__ __device__ __forceinline__ void stage_rc(int b, int& R, int& C) { const int st = b / 1024, sb = b % 1024, swz = sb ^ (((sb >> 9) & 1) << 5); R = (st >> 1) * 16 + swz / 64; C = (st & 1) * 32 + (swz % 64) / 2; }
__host__ __device__ __forceinline__ int perm32(int rho) { const int n = rho >> 4, i = rho & 15; return 8 * (i >> 2) + 4 * n + (i & 3); }

struct Unit { int pm, pn; const char* a; const char* b; };
struct Gemm { int lda, ldb, K; };

struct OrderBase {
    int nM, nN, nwg, G, c;
    __device__ void init(int nM_, int nN_, int G_, int c_) { nM = nM_; nN = nN_; nwg = nM * nN; G = G_; c = c_; }
    __device__ bool tile(int i, int& pm, int& pn) const {
        const long L = (long)i * G + c; if (L >= nwg) return false;
        int wgid = (int)L; { const int q = nwg / NXCD, r = nwg % NXCD, xcd = wgid % NXCD, off = wgid / NXCD; wgid = (xcd < r ? xcd * (q + 1) : r * (q + 1) + (xcd - r) * q) + off; }
        const int nig = WGM * nN, gid = wgid / nig, fm = gid * WGM, gsz = (nM - fm) < WGM ? (nM - fm) : WGM;
        pm = fm + ((wgid % nig) % gsz); pn = (wgid % nig) / gsz; return true;
    }
};
struct PlainOrder : OrderBase {
    const char* A; const char* Bt; size_t astep, bstep;
    __device__ void set(const void* A_, const void* Bt_, int lda, int ldb) { A = (const char*)A_; Bt = (const char*)Bt_; astep = (size_t)256 * lda * 2; bstep = (size_t)256 * ldb * 2; }
    __device__ bool next(int i, Unit& u) const { if (!tile(i, u.pm, u.pn)) return false; u.a = A + (size_t)u.pm * astep; u.b = Bt + (size_t)u.pn * bstep; return true; }
    __device__ __forceinline__ void a_ready(const Unit&) const {}
    __device__ __forceinline__ void done(const Unit&) const {}
};
struct QkvOrder : OrderBase {
    const char* ws;
    __device__ bool next(int i, Unit& u) const { if (!tile(i, u.pm, u.pn)) return false; const int which = u.pn >> 2, head = u.pn & 3;
        u.a = ws + (which < 2 ? WS_XC : WS_XM) + ((size_t)u.pm * 256 * 1024 + head * 256) * 2; u.b = ws + WS_WQKV + (size_t)u.pn * 256 * 256 * 2; return true; }
    __device__ __forceinline__ void a_ready(const Unit&) const {}
    __device__ __forceinline__ void done(const Unit&) const {}
};

__device__ __forceinline__ unsigned cvt_pk_bf16(float lo, float hi) { unsigned r; asm volatile("v_cvt_pk_bf16_f32 %0, %1, %2" : "=v"(r) : "v"(lo), "v"(hi)); return r; }
__device__ __forceinline__ float bf_lo(unsigned w) { return __uint_as_float(w << 16); }
__device__ __forceinline__ float bf_hi(unsigned w) { return __uint_as_float(w & 0xffff0000u); }
__device__ __forceinline__ float sigmoidf_fast(float v) { return __builtin_amdgcn_rcpf(1.0f + __builtin_amdgcn_exp2f(-1.4426950408889634f * v)); }


struct EpiProj {
    static constexpr bool PERM = true, AFTER_DRAIN = false;
    unsigned char* ws;
    const float* rope;
    __device__ __forceinline__ void operator()(const f32x4 (&acc)[2][2][4][2], const Unit& u, int wr, int wc, int fr, int fq) const {
        const int row0 = u.pm * BM + wr * 64 + fr; const int pn = u.pn;
        if (pn < 8) {
            const int hl = wc >> 1, e0 = 32 * (wc & 1) + 8 * fq;
            bf16_t* base; int ld;
            if (pn < 6) { base = (bf16_t*)(ws + WS_QA) + (pn * 2 + hl) * 128 + e0; ld = 1536; } else { base = (bf16_t*)(ws + WS_KA) + ((pn - 6) * 2 + hl) * 128 + e0; ld = 512; }
#pragma unroll
            for (int ai = 0; ai < 2; ++ai)
#pragma unroll
                for (int m = 0; m < 4; ++m) { const int r = row0 + ai * HALF + m * 16;
                    const f32x4* tb = (const f32x4*)(rope + (size_t)r * 128 + e0 * 2);
                    const f32x4 t0 = tb[0], t1 = tb[1], t2 = tb[2], t3 = tb[3];
                    const f32x4 x1a = acc[ai][0][m][0], x1b = acc[ai][0][m][1], x2a = acc[ai][1][m][0], x2b = acc[ai][1][m][1];
                    float o1[8], o2[8];
                    o1[0] = x1a[0] * t0[0] - x2a[0] * t0[1]; o2[0] = x2a[0] * t0[0] + x1a[0] * t0[1];
                    o1[1] = x1a[1] * t0[2] - x2a[1] * t0[3]; o2[1] = x2a[1] * t0[2] + x1a[1] * t0[3];
                    o1[2] = x1a[2] * t1[0] - x2a[2] * t1[1]; o2[2] = x2a[2] * t1[0] + x1a[2] * t1[1];
                    o1[3] = x1a[3] * t1[2] - x2a[3] * t1[3]; o2[3] = x2a[3] * t1[2] + x1a[3] * t1[3];
                    o1[4] = x1b[0] * t2[0] - x2b[0] * t2[1]; o2[4] = x2b[0] * t2[0] + x1b[0] * t2[1];
                    o1[5] = x1b[1] * t2[2] - x2b[1] * t2[3]; o2[5] = x2b[1] * t2[2] + x1b[1] * t2[3];
                    o1[6] = x1b[2] * t3[0] - x2b[2] * t3[1]; o2[6] = x2b[2] * t3[0] + x1b[2] * t3[1];
                    o1[7] = x1b[3] * t3[2] - x2b[3] * t3[3]; o2[7] = x2b[3] * t3[2] + x1b[3] * t3[3];
                    u32x4 w1, w2;
                    w1.x = cvt_pk_bf16(o1[0], o1[1]); w1.y = cvt_pk_bf16(o1[2], o1[3]); w1.z = cvt_pk_bf16(o1[4], o1[5]); w1.w = cvt_pk_bf16(o1[6], o1[7]);
                    w2.x = cvt_pk_bf16(o2[0], o2[1]); w2.y = cvt_pk_bf16(o2[2], o2[3]); w2.z = cvt_pk_bf16(o2[4], o2[5]); w2.w = cvt_pk_bf16(o2[6], o2[7]);
                    bf16_t* rp = base + (size_t)r * ld;
                    *(u32x4*)rp = w1; *(u32x4*)(rp + 64) = w2; }
        } else {
            bf16_t* base; int ld, act, ct;
            if (pn < 10)      { base = (bf16_t*)(ws + WS_VA); ld = 512;  act = 0; ct = pn - 8; }
            else if (pn < 12) { base = (bf16_t*)(ws + WS_ZA); ld = 512;  act = 1; ct = pn - 10; }
            else if (pn < 16) { base = (bf16_t*)(ws + WS_XM); ld = 1024; act = 0; ct = pn - 12; }
            else if (pn < 20) { base = (bf16_t*)(ws + WS_ZM); ld = 1024; act = 1; ct = pn - 16; }
            else if (pn < 24) { base = (bf16_t*)(ws + WS_OM); ld = 1024; act = 2; ct = pn - 20; }
            else if (pn < 28) { base = (bf16_t*)(ws + WS_GA); ld = 1024; act = 2; ct = pn - 24; }
            else              { base = (bf16_t*)(ws + WS_GM); ld = 1024; act = 2; ct = pn - 28; }
            const int col0 = ct * BM + wc * 32 + 8 * fq;
#pragma unroll
            for (int ai = 0; ai < 2; ++ai)
#pragma unroll
                for (int m = 0; m < 4; ++m) { bf16_t* rowp = base + (size_t)(row0 + ai * HALF + m * 16) * ld + col0;
#pragma unroll
                    for (int bj = 0; bj < 2; ++bj) { f32x4 v0 = acc[ai][bj][m][0], v1 = acc[ai][bj][m][1];
                        if (act != 0) {
#pragma unroll
                            for (int j = 0; j < 4; ++j) { const float s0 = sigmoidf_fast(v0[j]), s1 = sigmoidf_fast(v1[j]); v0[j] = (act == 1) ? v0[j] * s0 : s0; v1[j] = (act == 1) ? v1[j] * s1 : s1; } }
                        u32x4 w; w.x = cvt_pk_bf16(v0[0], v0[1]); w.y = cvt_pk_bf16(v0[2], v0[3]); w.z = cvt_pk_bf16(v1[0], v1[1]); w.w = cvt_pk_bf16(v1[2], v1[3]);
                        *(u32x4*)(rowp + bj * HALF) = w; } }
        }
    }
};
struct EpiQkv {
    static constexpr bool PERM = true, AFTER_DRAIN = false;
    unsigned char* ws;
    __device__ __forceinline__ void operator()(const f32x4 (&acc)[2][2][4][2], const Unit& u, int wr, int wc, int fr, int fq) const {
        const int which = u.pn >> 2, head = u.pn & 3; bf16_t* base = (bf16_t*)(ws + (which == 0 ? WS_QM : (which == 1 ? WS_KM : WS_VM))); const float sc = which == 1 ? 0.0625f : 1.0f;
        const int row0 = u.pm * BM + wr * 64 + fr, col0 = head * 256 + wc * 32 + 8 * fq;
#pragma unroll
        for (int ai = 0; ai < 2; ++ai)
#pragma unroll
            for (int m = 0; m < 4; ++m) { bf16_t* rowp = base + (size_t)(row0 + ai * HALF + m * 16) * 1024 + col0;
#pragma unroll
                for (int bj = 0; bj < 2; ++bj) { const f32x4 v0 = acc[ai][bj][m][0] * sc, v1 = acc[ai][bj][m][1] * sc;
                    u32x4 w; w.x = cvt_pk_bf16(v0[0], v0[1]); w.y = cvt_pk_bf16(v0[2], v0[3]); w.z = cvt_pk_bf16(v1[0], v1[1]); w.w = cvt_pk_bf16(v1[2], v1[3]);
                    *(u32x4*)(rowp + bj * HALF) = w; } }
    }
};
template <int MODE> struct EpiGate {
    static constexpr bool PERM = true, AFTER_DRAIN = false;
    const bf16_t* G; bf16_t* P;
    __device__ __forceinline__ void operator()(const f32x4 (&acc)[2][2][4][2], const Unit& u, int wr, int wc, int fr, int fq) const {
        const int row0 = u.pm * BM + wr * 64 + fr, col0 = u.pn * BM + wc * 32 + 8 * fq;
#pragma unroll
        for (int ai = 0; ai < 2; ++ai)
#pragma unroll
            for (int m = 0; m < 4; ++m) { const size_t off = (size_t)(row0 + ai * HALF + m * 16) * 1024 + col0;
#pragma unroll
                for (int bj = 0; bj < 2; ++bj) { const u32x4 g = *(const u32x4*)(G + off + bj * HALF); const f32x4 a0 = acc[ai][bj][m][0], a1 = acc[ai][bj][m][1];
                    float o[8];
                    o[0] = bf_lo(g.x) * a0[0]; o[1] = bf_hi(g.x) * a0[1]; o[2] = bf_lo(g.y) * a0[2]; o[3] = bf_hi(g.y) * a0[3];
                    o[4] = bf_lo(g.z) * a1[0]; o[5] = bf_hi(g.z) * a1[1]; o[6] = bf_lo(g.w) * a1[2]; o[7] = bf_hi(g.w) * a1[3];
                    if (MODE == 1) { const u32x4 p = *(const u32x4*)(P + off + bj * HALF);
                        o[0] += bf_lo(p.x); o[1] += bf_hi(p.x); o[2] += bf_lo(p.y); o[3] += bf_hi(p.y); o[4] += bf_lo(p.z); o[5] += bf_hi(p.z); o[6] += bf_lo(p.w); o[7] += bf_hi(p.w); }
                    u32x4 w; w.x = cvt_pk_bf16(o[0], o[1]); w.y = cvt_pk_bf16(o[2], o[3]); w.z = cvt_pk_bf16(o[4], o[5]); w.w = cvt_pk_bf16(o[6], o[7]);
                    *(u32x4*)(P + off + bj * HALF) = w; } }
    }
};
struct EpiRes {
    static constexpr bool PERM = false, AFTER_DRAIN = false;
    const float* x; float* out; const float* gate; int grow0; float alpha;
    __device__ __forceinline__ void operator()(const f32x4 (&acc)[2][2][4][2], const Unit& u, int wr, int wc, int fr, int fq) const {
        const int row0 = u.pm * BM + wr * 64 + fr, col0 = u.pn * BM + wc * 32 + 4 * fq;
        const int b = (grow0 + u.pm * BM) >> 12;
        f32x4 gv[2][2];
#pragma unroll
        for (int bj = 0; bj < 2; ++bj)
#pragma unroll
            for (int n = 0; n < 2; ++n) gv[bj][n] = *(const f32x4*)(gate + (size_t)b * 3072 + col0 + bj * HALF + n * 16);
#pragma unroll
        for (int ai = 0; ai < 2; ++ai)
#pragma unroll
            for (int m = 0; m < 4; ++m) { const size_t off = (size_t)(row0 + ai * HALF + m * 16) * 1024 + col0;
#pragma unroll
                for (int bj = 0; bj < 2; ++bj)
#pragma unroll
                    for (int n = 0; n < 2; ++n) { const f32x4 xv = *(const f32x4*)(x + off + bj * HALF + n * 16); *(f32x4*)(out + off + bj * HALF + n * 16) = xv * alpha + gv[bj][n] * acc[ai][bj][m][n]; } }
    }
};

template <class Epi, class Sched, bool ALIGN_EPI = false, bool SP2 = false>
__device__ __forceinline__ void gemm_phase(PG8_LAS unsigned char* lds, const Gemm g, const Sched& S, const Epi& E, const int tid) {
    const int wid = __builtin_amdgcn_readfirstlane(tid >> 6), lane = tid & 63, wr = wid >> 2, wc = wid & 3, fr = lane & 15, fq = lane >> 4;
    const int K = g.K, nt = K / BK;
    unsigned voffA[2], voffB[2];
#pragma unroll
    for (int i = 0; i < 2; ++i) { int R, C; stage_rc(tid * 16 + i * 8192, R, C); const int Rb = Epi::PERM ? ((R & ~31) + perm32(R & 31)) : R;
        voffA[i] = (unsigned)(R * g.lda + C) * 2u; voffB[i] = (unsigned)(Rb * g.ldb + C) * 2u; }
    const size_t kstep = (size_t)(BK * 2);
    const size_t hstepA = (size_t)HALF * g.lda * 2, hstepB = (size_t)HALF * g.ldb * 2;
    const unsigned ldsw = (unsigned)wid * 1024u;
    const int aoff = lds_byte(wr * 64 + fr, fq * 8), boff = lds_byte(wc * 32 + fr, fq * 8);
#define PG8_SA(b, h) (((b) * 2 + (h)) * HTB)
#define PG8_SB(b, h) ((4 + (b) * 2 + (h)) * HTB)
#define PG8_STAGE(bufoff, gbase, voff) do { _Pragma("unroll") for (int _i = 0; _i < 2; ++_i) \
        __builtin_amdgcn_global_load_lds((const unsigned*)((const char*)(gbase) + (voff)[_i]), (PG8_LAS unsigned*)(lds + (bufoff) + ldsw + _i * 8192), 16, 0, 0); } while (0)
#define PG8_LDA(dst, b, h) do { _Pragma("unroll") for (int m = 0; m < 4; ++m) _Pragma("unroll") for (int k = 0; k < 2; ++k) dst[m][k] = *(const PG8_LAS bf16x8*)(lds + PG8_SA(b, h) + aoff + m * 2048 + k * 1024); } while (0)
#define PG8_LDB(dst, b, h) do { _Pragma("unroll") for (int n = 0; n < 2; ++n) _Pragma("unroll") for (int k = 0; k < 2; ++k) dst[n][k] = *(const PG8_LAS bf16x8*)(lds + PG8_SB(b, h) + boff + n * 2048 + k * 1024); } while (0)
#define PG8_MMA(ai, bj, At, Bt) do { __builtin_amdgcn_s_setprio(1); _Pragma("unroll") for (int m = 0; m < 4; ++m) _Pragma("unroll") for (int n = 0; n < 2; ++n) _Pragma("unroll") for (int k = 0; k < 2; ++k) \
        acc[ai][bj][m][n] = __builtin_amdgcn_mfma_f32_16x16x32_bf16(Bt[n][k], At[m][k], acc[ai][bj][m][n], 0, 0, 0); __builtin_amdgcn_s_setprio(0); } while (0)
#define PG8_WAIT_V(n) asm volatile("s_waitcnt vmcnt(" #n ")" ::: "memory")
#define PG8_WAIT_L(n) asm volatile("s_waitcnt lgkmcnt(" #n ")" ::: "memory")
#define PG8_BAR __builtin_amdgcn_s_barrier()
#define PG8_SCHED __builtin_amdgcn_sched_barrier(0)
    Unit cur, nxt; int ui = 0;
    if (!S.next(0, cur)) return;
    f32x4 acc[2][2][4][2];
#pragma unroll
    for (int a = 0; a < 2; ++a)
#pragma unroll
        for (int b = 0; b < 2; ++b)
#pragma unroll
            for (int m = 0; m < 4; ++m)
#pragma unroll
                for (int n = 0; n < 2; ++n) acc[a][b][m][n] = (f32x4){0.f, 0.f, 0.f, 0.f};
    bf16x8 At[4][2], B0[2][2], B1[2][2];
    const char* cA = cur.a; const char* cB = cur.b;
    S.a_ready(cur);
    if constexpr (SP2) {
        PG8_STAGE(PG8_SB(0, 0), cB, voffB); PG8_STAGE(PG8_SB(0, 1), cB + hstepB, voffB); PG8_STAGE(PG8_SA(0, 0), cA, voffA); PG8_STAGE(PG8_SA(0, 1), cA + hstepA, voffA);
        if (wr == 1) PG8_BAR;
        PG8_WAIT_V(2); PG8_BAR;
        PG8_STAGE(PG8_SB(1, 0), cB + kstep, voffB); PG8_STAGE(PG8_SA(1, 0), cA + kstep, voffA); PG8_STAGE(PG8_SB(1, 1), cB + hstepB + kstep, voffB);
        PG8_WAIT_V(6); PG8_BAR;
    } else {
        PG8_STAGE(PG8_SB(0, 0), cB, voffB); PG8_STAGE(PG8_SA(0, 0), cA, voffA); PG8_STAGE(PG8_SB(0, 1), cB + hstepB, voffB); PG8_STAGE(PG8_SA(0, 1), cA + hstepA, voffA);
        if (wr == 1) PG8_BAR;
        PG8_WAIT_V(4); PG8_BAR;
        PG8_STAGE(PG8_SB(1, 0), cB + kstep, voffB); PG8_STAGE(PG8_SA(1, 0), cA + kstep, voffA); PG8_STAGE(PG8_SB(1, 1), cB + hstepB + kstep, voffB);
        PG8_WAIT_V(6); PG8_BAR;
    }
    for (;;) {
        const bool has_next = S.next(ui + 1, nxt);
        const char* nA = has_next ? nxt.a : cA; const char* nB = has_next ? nxt.b : cB;
        for (int t = 0; t < nt; t += 2) {
            const bool last = (t == nt - 2);
            const char* a1 = cA + (size_t)(t + 1) * kstep;
            const char* a2 = last ? nA : cA + (size_t)(t + 2) * kstep; const char* b2 = last ? nB : cB + (size_t)(t + 2) * kstep;
            const char* a3 = a2 + kstep; const char* b3 = b2 + kstep;
            if (last && has_next) S.a_ready(nxt);
            if constexpr (SP2) {
            PG8_LDB(B0, 0, 0); PG8_LDB(B1, 0, 1); PG8_SCHED; PG8_LDA(At, 0, 0); PG8_STAGE(PG8_SA(1, 1), a1 + hstepA, voffA);
            PG8_WAIT_V(8); PG8_WAIT_L(0); PG8_BAR; PG8_MMA(0, 0, At, B0); PG8_MMA(0, 1, At, B1); PG8_BAR; PG8_SCHED;
            PG8_LDA(At, 0, 1); PG8_STAGE(PG8_SB(0, 0), b2, voffB); PG8_STAGE(PG8_SB(0, 1), b2 + hstepB, voffB); PG8_STAGE(PG8_SA(0, 0), a2, voffA);
            PG8_WAIT_V(8); PG8_WAIT_L(0); PG8_BAR; PG8_MMA(1, 0, At, B0); PG8_MMA(1, 1, At, B1); PG8_BAR; PG8_SCHED;
            PG8_LDB(B0, 1, 0); PG8_LDB(B1, 1, 1); PG8_SCHED; PG8_LDA(At, 1, 0); PG8_STAGE(PG8_SA(0, 1), a2 + hstepA, voffA);
            PG8_WAIT_V(8); PG8_WAIT_L(0); PG8_BAR; PG8_MMA(0, 0, At, B0); PG8_MMA(0, 1, At, B1); PG8_BAR; PG8_SCHED;
            PG8_LDA(At, 1, 1); PG8_STAGE(PG8_SB(1, 0), b3, voffB); PG8_STAGE(PG8_SB(1, 1), b3 + hstepB, voffB); PG8_STAGE(PG8_SA(1, 0), a3, voffA);
            PG8_WAIT_V(8); PG8_WAIT_L(0); PG8_BAR; PG8_MMA(1, 0, At, B0); PG8_MMA(1, 1, At, B1); PG8_BAR; PG8_SCHED;
            } else {
            PG8_LDB(B0, 0, 0); PG8_SCHED; PG8_LDA(At, 0, 0); PG8_STAGE(PG8_SA(1, 1), a1 + hstepA, voffA);
            PG8_WAIT_L(8); PG8_BAR; PG8_WAIT_L(0); PG8_MMA(0, 0, At, B0); PG8_BAR; PG8_SCHED;
            PG8_LDB(B1, 0, 1); PG8_STAGE(PG8_SB(0, 0), b2, voffB);
            PG8_BAR; PG8_WAIT_L(0); PG8_MMA(0, 1, At, B1); PG8_BAR;
            PG8_LDA(At, 0, 1); PG8_STAGE(PG8_SA(0, 0), a2, voffA);
            PG8_BAR; PG8_WAIT_L(0); PG8_MMA(1, 0, At, B0); PG8_BAR; PG8_SCHED;
            PG8_STAGE(PG8_SB(0, 1), b2 + hstepB, voffB);
            PG8_WAIT_V(6); PG8_BAR; PG8_MMA(1, 1, At, B1); PG8_BAR;
            PG8_LDB(B0, 1, 0); PG8_SCHED; PG8_LDA(At, 1, 0); PG8_STAGE(PG8_SA(0, 1), a2 + hstepA, voffA);
            PG8_WAIT_L(8); PG8_BAR; PG8_WAIT_L(0); PG8_MMA(0, 0, At, B0); PG8_BAR; PG8_SCHED;
            PG8_LDB(B1, 1, 1); PG8_STAGE(PG8_SB(1, 0), b3, voffB);
            PG8_BAR; PG8_WAIT_L(0); PG8_MMA(0, 1, At, B1); PG8_BAR;
            PG8_LDA(At, 1, 1); PG8_STAGE(PG8_SA(1, 0), a3, voffA);
            PG8_BAR; PG8_WAIT_L(0); PG8_MMA(1, 0, At, B0); PG8_BAR; PG8_SCHED;
            PG8_STAGE(PG8_SB(1, 1), b3 + hstepB, voffB);
            PG8_WAIT_V(6); PG8_BAR; PG8_MMA(1, 1, At, B1); PG8_BAR;
            }
        }
        if constexpr (ALIGN_EPI) { if (wr == 0) PG8_BAR; }
        if constexpr (!Epi::AFTER_DRAIN) { E(acc, cur, wr, wc, fr, fq); S.done(cur); }
        if (!has_next) break;
#pragma unroll
        for (int a = 0; a < 2; ++a)
#pragma unroll
            for (int b = 0; b < 2; ++b)
#pragma unroll
                for (int m = 0; m < 4; ++m)
#pragma unroll
                    for (int n = 0; n < 2; ++n) acc[a][b][m][n] = (f32x4){0.f, 0.f, 0.f, 0.f};
        cur = nxt; cA = nA; cB = nB; ++ui;
        if constexpr (ALIGN_EPI) { if (wr == 1) PG8_BAR; }
    }
    PG8_WAIT_V(0);
    if constexpr (!ALIGN_EPI) { if (wr == 0) PG8_BAR; }
    PG8_BAR;
    if constexpr (Epi::AFTER_DRAIN) { E.fused(acc, cur, wr, wc, fr, fq, lds, wid, lane); S.done(cur); }
#undef PG8_SA
#undef PG8_SB
#undef PG8_STAGE
#undef PG8_LDA
#undef PG8_LDB
#undef PG8_MMA
#undef PG8_WAIT_V
#undef PG8_WAIT_L
#undef PG8_BAR
#undef PG8_SCHED
}
}
#define GAS __attribute__((address_space(1)))
#define LAS __attribute__((address_space(3)))
typedef unsigned short bf16;
typedef unsigned v4u __attribute__((ext_vector_type(4)));
typedef unsigned v2u __attribute__((ext_vector_type(2)));
typedef float f32x4 __attribute__((ext_vector_type(4)));
typedef float f32x2 __attribute__((ext_vector_type(2)));
typedef GAS unsigned gu32;
#define RLX_AGENT __ATOMIC_RELAXED, __HIP_MEMORY_SCOPE_AGENT
#define LDS_WAIT() asm volatile("s_waitcnt lgkmcnt(0)" ::: "memory")
#define VM_WAIT() asm volatile("s_waitcnt vmcnt(0)" ::: "memory")
__device__ __forceinline__ unsigned f2bf(float f) { unsigned u = __builtin_bit_cast(unsigned, f); return (u + 0x7fffu + ((u >> 16) & 1u)) >> 16; }
__device__ __forceinline__ unsigned pk2(float lo, float hi) { return f2bf(lo) | (f2bf(hi) << 16); }
__device__ __forceinline__ float bflo(unsigned w) { return __uint_as_float(w << 16); }
__device__ __forceinline__ float bfhi(unsigned w) { return __uint_as_float(w & 0xffff0000u); }
__device__ __forceinline__ float bf2f(bf16 b) { return __uint_as_float(((unsigned)b) << 16); }

#define XB_TMO      128
#define XB_XCNT(j)  (256  + 64 * (j))
#define XB_XSUB(j)  (1280 + 64 * (j))
#define XB_XGEN(j)  (2304 + 64 * (j))
#define XB_TOP      3328
#define XB_TOPGEN   3392
#define XCD_BAR_WORDS 3456
#define XB_SPIN_CAP (1u << 22)

__device__ __forceinline__ unsigned xb_ld(unsigned* p)              { return __hip_atomic_load(p, __ATOMIC_RELAXED, __HIP_MEMORY_SCOPE_AGENT); }
__device__ __forceinline__ unsigned xb_add(unsigned* p, unsigned v) { return __hip_atomic_fetch_add(p, v, __ATOMIC_RELAXED, __HIP_MEMORY_SCOPE_AGENT); }
__device__ __forceinline__ unsigned xb_xcc_id() { return (unsigned)__builtin_amdgcn_s_getreg((3 << 11) | 20) & 0xFu; }
#define XB_SPIN(cond, bar) do { unsigned _sp = 0; while (cond) { __builtin_amdgcn_s_sleep(1); \
    if ((++_sp & 255u) == 0u) { if (xb_ld(&(bar)[XB_TMO])) break; if (_sp > XB_SPIN_CAP) { atomicAdd(&(bar)[XB_TMO], 1u); break; } } } } while (0)

struct XcdBarrier { unsigned* bar; unsigned x; volatile LAS unsigned* st; };
__device__ __forceinline__ XcdBarrier xcd_barrier_post(unsigned* bar, volatile LAS unsigned* st) {
    XcdBarrier b; b.bar = bar; b.x = xb_xcc_id(); b.st = st;
    if (threadIdx.x == 0) (void)xb_add(&bar[XB_XCNT(b.x)], 1u);
    return b;
}
__device__ __forceinline__ void xcd_barrier_complete(unsigned* bar, unsigned x, unsigned& nloc, unsigned& nx) {
    const unsigned G = gridDim.x * gridDim.y * gridDim.z;
    unsigned sum, cnt, mine, sp = 0u;
    for (;;) {
        sum = 0u; cnt = 0u; mine = 0u;
#pragma unroll
        for (unsigned j = 0; j < 16; ++j) { const unsigned c = xb_ld(&bar[XB_XCNT(j)]); sum += c; cnt += (c > 0u) ? 1u : 0u; mine = (j == x) ? c : mine; }
        if (sum == G) break;
        __builtin_amdgcn_s_sleep(1);
        if ((++sp & 255u) == 0u) { if (xb_ld(&bar[XB_TMO])) break; if (sp > XB_SPIN_CAP) { atomicAdd(&bar[XB_TMO], 1u); break; } }
    }
    nloc = mine > 0u ? mine : 1u; nx = cnt > 0u ? cnt : 1u;
}
__device__ __forceinline__ void xcd_barrier(const XcdBarrier& b) {
    asm volatile("s_waitcnt vmcnt(0)" ::: "memory");
    __syncthreads();
    if (threadIdx.x == 0) {
        unsigned* bar = b.bar;
        __builtin_amdgcn_s_waitcnt(0);
        unsigned nloc = b.st[0], nx = b.st[1];
        if (nloc == 0u) { xcd_barrier_complete(bar, b.x, nloc, nx); b.st[0] = nloc; b.st[1] = nx; }
        const unsigned old = xb_add(&bar[XB_XSUB(b.x)], 1u);
        const unsigned gen = old / nloc;
        if (old + 1u == (gen + 1u) * nloc) {
            __builtin_amdgcn_fence(__ATOMIC_RELEASE, "agent");
            asm volatile("s_waitcnt vmcnt(0)" ::: "memory");
            const unsigned og = xb_add(&bar[XB_TOP], 1u);
            const unsigned tg = og / nx;
            if (og + 1u == (tg + 1u) * nx) xb_add(&bar[XB_TOPGEN], 1u);
            else XB_SPIN(xb_ld(&bar[XB_TOPGEN]) == tg, bar);
            __builtin_amdgcn_fence(__ATOMIC_ACQUIRE, "agent");
            xb_add(&bar[XB_XGEN(b.x)], 1u);
            asm volatile("s_waitcnt vmcnt(0)" ::: "memory");
        } else {
            XB_SPIN(xb_ld(&bar[XB_XGEN(b.x)]) == gen, bar);
            __builtin_amdgcn_fence(__ATOMIC_ACQUIRE, "agent");
            asm volatile("s_waitcnt vmcnt(0)" ::: "memory");
        }
    }
    __syncthreads();
}

struct Frame {
    LAS unsigned char* lds;
    volatile LAS unsigned* MISC;
    gu32* ctl;
    int tid, lane, wave;
    int vcu, G;
    unsigned char* ws;
    float* out;
};
__device__ __forceinline__ float wave_sum(float v) {
#pragma unroll
    for (int o = 1; o < 64; o <<= 1) v += __shfl_xor(v, o);
    return v;
}
namespace swa {
constexpr float SCALE = 0.08838834764831845f;
constexpr int D = 128, NW = 8, QBLK = 32, KVBLK = 64, QB = NW * QBLK;
constexpr int SHM_V = KVBLK * D * 2, SHM_K = KVBLK * D * 2;
constexpr int LDS_BYTES = 2 * SHM_V + 2 * SHM_K + NW * 64 * 4;
constexpr float THR = 8.f;
constexpr int WIN = 129;
constexpr bool WSKIP = true;
constexpr unsigned VOFF = (unsigned)(WS_VA - WS_KA);
typedef unsigned short bf16;
typedef short bf16x8 __attribute__((ext_vector_type(8)));
typedef short s16x4 __attribute__((ext_vector_type(4)));
typedef float f32x16 __attribute__((ext_vector_type(16)));
typedef float f32x4 __attribute__((ext_vector_type(4)));
typedef unsigned u32x4 __attribute__((ext_vector_type(4)));

#define KSWZ(row, colB) ((row) * 256 + ((colB) ^ (((row) & 7) << 4)))
#define SBAR() __builtin_amdgcn_sched_barrier(0)
__device__ __forceinline__ int v_st(int k, int c) { const int kk = (k & ~0xC) | ((k & 4) << 1) | ((k & 8) >> 1); return ((kk >> 3) * 4 + (c >> 5)) * 512 + ((kk & 7) * 32 + (c & 31)) * 2; }
__device__ __forceinline__ int v_rd_base(int lane) { return ((lane & 3) << 3) | (((lane >> 2) & 3) << 6) | (((lane >> 4) & 1) << 5) | (((lane >> 5) & 1) << 8); }
constexpr int v_rd_off(int d0, int ks, int half) { return d0 * 512 + ks * 4096 + half * 2048; }
__device__ __forceinline__ int crow(int r, int hi) { return (r & 3) + 8 * (r >> 2) + 4 * hi; }
__device__ __forceinline__ unsigned cvtpk(float lo, float hi) {
    unsigned r; asm volatile("v_cvt_pk_bf16_f32 %0, %1, %2" : "=v"(r) : "v"(lo), "v"(hi)); return r;
}
__device__ __forceinline__ bf16x8 pack8(f32x4 a, f32x4 b) {
    u32x4 w = {cvtpk(a[0], a[1]), cvtpk(a[2], a[3]), cvtpk(b[0], b[1]), cvtpk(b[2], b[3])};
    return *reinterpret_cast<bf16x8*>(&w);
}
__device__ __forceinline__ bf16x8 load8(const bf16* p) { return *reinterpret_cast<const bf16x8*>(p); }
__device__ __forceinline__ void mask_tile(f32x16& p0, f32x16& p1, int dq, unsigned W) {
    const float NEG = -__builtin_inff();
#pragma unroll
    for (int r = 0; r < 16; ++r) {
        const int c = (r & 3) + 8 * (r >> 2);
        if ((unsigned)(dq - c) >= W) p0[r] = NEG;
        if ((unsigned)(dq - c - 32) >= W) p1[r] = NEG;
    }
}
__device__ __forceinline__ void partialSM(f32x16& p0, f32x16& p1, float& m_reg, float& mn, float& alpha) {
    float pmax = p0[0]; for (int r = 1; r < 16; ++r) pmax = fmaxf(pmax, p0[r]); for (int r = 0; r < 16; ++r) pmax = fmaxf(pmax, p1[r]);
    { auto rr = __builtin_amdgcn_permlane32_swap(__float_as_uint(pmax), __float_as_uint(pmax), false, false);
      pmax = fmaxf(__uint_as_float(rr[0]), __uint_as_float(rr[1])); }
    constexpr float C2 = 1.4426950408889634f * SCALE;
    if (__builtin_expect(__all((pmax - m_reg) * SCALE <= THR), 1)) { mn = m_reg; alpha = 1.f; }
    else { mn = fmaxf(m_reg, pmax); alpha = __builtin_amdgcn_exp2f((m_reg - mn) * C2); m_reg = mn; }
    const float mnL = -mn * C2;
    for (int r = 0; r < 16; ++r) p0[r] = fmaf(p0[r], C2, mnL); for (int r = 0; r < 16; ++r) p1[r] = fmaf(p1[r], C2, mnL);
    for (int r = 0; r < 16; ++r) p0[r] = __builtin_amdgcn_exp2f(p0[r]);
}
__device__ __forceinline__ void finishSM(f32x16& p0, f32x16& p1, float alpha, float& l_reg, bf16x8& pa0, bf16x8& pa1, bf16x8& pa2, bf16x8& pa3) {
    for (int r = 0; r < 16; ++r) p1[r] = __builtin_amdgcn_exp2f(p1[r]);
    float ps = 0; for (int r = 0; r < 16; ++r) ps += p0[r]; for (int r = 0; r < 16; ++r) ps += p1[r];
    { auto rr = __builtin_amdgcn_permlane32_swap(__float_as_uint(ps), __float_as_uint(ps), false, false);
      ps = __uint_as_float(rr[0]) + __uint_as_float(rr[1]); }
    l_reg = l_reg * alpha + ps;
#define PK4(P, B_, OUT) do { unsigned a0 = cvtpk(P[B_+0], P[B_+1]), a1 = cvtpk(P[B_+2], P[B_+3]);                          \
        unsigned b0 = cvtpk(P[B_+4], P[B_+5]), b1 = cvtpk(P[B_+6], P[B_+7]);                                             \
        auto r0 = __builtin_amdgcn_permlane32_swap(a0, b0, false, false); auto r1 = __builtin_amdgcn_permlane32_swap(a1, b1, false, false); \
        u32x4 w = {r0[0], r1[0], r0[1], r1[1]}; OUT = *reinterpret_cast<bf16x8*>(&w); } while (0)
    PK4(p0, 0, pa0); PK4(p0, 8, pa1); PK4(p1, 0, pa2); PK4(p1, 8, pa3);
#undef PK4
}
template <int KB, bool SK>
__device__ __forceinline__ void qkt(f32x16& p0, f32x16& p1, const char* K_lds, int r32, int hi, const bf16x8* qr, bool act) {
    if (SK && !act) { const float NEG = -__builtin_inff();
#pragma unroll
        for (int r = 0; r < 16; ++r) { p0[r] = NEG; p1[r] = NEG; } return; }
    p0 = f32x16{}; p1 = f32x16{};
    const char* kb[4];
#pragma unroll
    for (int dd = 0; dd < 4; ++dd) kb[dd] = K_lds + KB * SHM_K + KSWZ(r32, (dd * 16 + hi * 8) * 2);
#pragma unroll
    for (int d0 = 0; d0 < 8; ++d0) { const char* a = kb[d0 & 3] + (d0 >> 2) * 128;
        bf16x8 b0 = *reinterpret_cast<const bf16x8*>(a);
        bf16x8 b1 = *reinterpret_cast<const bf16x8*>(a + 32 * 256);
        p0 = __builtin_amdgcn_mfma_f32_32x32x16_bf16(b0, qr[d0], p0, 0, 0, 0);
        p1 = __builtin_amdgcn_mfma_f32_32x32x16_bf16(b1, qr[d0], p1, 0, 0, 0); }
}
template <int VB, bool SK>
__device__ __forceinline__ void pv_tile(f32x16* o, int vb0, bf16x8 pa0, bf16x8 pa1, bf16x8 pa2, bf16x8 pa3, bool act) {
    if (SK && !act) return;
#define TRRD(dst, off) asm volatile("ds_read_b64_tr_b16 %0, %1 offset:%2" : "=&v"(dst) : "v"(vb0), "i"(off) : "memory")
#define PV_D0(d0) do { s16x4 l0, l1, l2, l3, h0, h1, h2, h3; constexpr int b_ = VB * SHM_V + v_rd_off(d0, 0, 0);     \
        TRRD(l0, b_); TRRD(h0, b_ + 2048); TRRD(l1, b_ + 4096); TRRD(h1, b_ + 6144); TRRD(l2, b_ + 8192); TRRD(h2, b_ + 10240); TRRD(l3, b_ + 12288); TRRD(h3, b_ + 14336); \
        asm volatile("s_waitcnt lgkmcnt(0)" ::: "memory"); SBAR();                 \
        o[d0] = __builtin_amdgcn_mfma_f32_32x32x16_bf16(pa0, (bf16x8){l0[0], l0[1], l0[2], l0[3], h0[0], h0[1], h0[2], h0[3]}, o[d0], 0, 0, 0);   \
        o[d0] = __builtin_amdgcn_mfma_f32_32x32x16_bf16(pa1, (bf16x8){l1[0], l1[1], l1[2], l1[3], h1[0], h1[1], h1[2], h1[3]}, o[d0], 0, 0, 0);   \
        o[d0] = __builtin_amdgcn_mfma_f32_32x32x16_bf16(pa2, (bf16x8){l2[0], l2[1], l2[2], l2[3], h2[0], h2[1], h2[2], h2[3]}, o[d0], 0, 0, 0);   \
        o[d0] = __builtin_amdgcn_mfma_f32_32x32x16_bf16(pa3, (bf16x8){l3[0], l3[1], l3[2], l3[3], h3[0], h3[1], h3[2], h3[3]}, o[d0], 0, 0, 0); } while (0)
    PV_D0(0); PV_D0(1); PV_D0(2); PV_D0(3);
#undef PV_D0
#undef TRRD
}


struct BlockRef { unsigned q, k, o, l; int P0, qp, kp, skv; };
struct Seam { bf16x8 qr[8]; bf16x8 st_v0, st_v1, st_k0, st_k1; };
__device__ __forceinline__ int swa_jlo(int P0) { const int lowk = P0 - WIN + 1; return lowk > 0 ? lowk / KVBLK : 0; }
#define VMW() asm volatile("s_waitcnt vmcnt(0)" ::: "memory")
#define VMWN(n) asm volatile("s_waitcnt vmcnt(%0)" :: "i"(n) : "memory")
#define SLOAD_H(Kp, Vp, k0, pitch, lo) do { const bf16* kr_ = (Kp) + (size_t)(k0) * (pitch); const bf16* vr_ = (Vp) + (size_t)(k0) * (pitch); const size_t h_ = (size_t)32 * (pitch); \
                         S.st_v0 = load8(vr_ + (lo)); S.st_v1 = load8(vr_ + h_ + (lo)); S.st_k0 = load8(kr_ + (lo)); S.st_k1 = load8(kr_ + h_ + (lo)); } while (0)
#define SWRITE_HK(bf) do { *(bf16x8*)(K_lds + (bf) * SHM_K + kws) = S.st_k0; *(bf16x8*)(K_lds + (bf) * SHM_K + kws + 32 * 256) = S.st_k1; } while (0)
#define SWRITE_HV(bf) do { *(bf16x8*)(V_lds + (bf) * SHM_V + vst0) = S.st_v0; *(bf16x8*)(V_lds + (bf) * SHM_V + vst1) = S.st_v1; } while (0)
#define SWRITE_H(bf) do { SWRITE_HV(bf); SWRITE_HK(bf); } while (0)
__device__ __forceinline__ void swa_prime(const unsigned char* wsb, const BlockRef& cur, char* lds, Seam& S, const int tid) {
    const int wid = __builtin_amdgcn_readfirstlane(tid >> 6), lane = tid & 63, r32 = lane & 31, hi = lane >> 5;
    const int sr = tid >> 4, sc = (tid & 15) * 8, kws = KSWZ(sr, sc * 2); char* K_lds = lds + 2 * SHM_V;
    const int kb0 = swa_jlo(cur.P0) * KVBLK;
    { const unsigned qlo = (unsigned)((wid * QBLK + r32) * cur.qp + hi * 8); const bf16* qb_ = (const bf16*)(wsb + cur.q);
      for (int d0 = 0; d0 < 8; ++d0) S.qr[d0] = load8((qb_ + qlo) + d0 * 16); }
    { const unsigned lo = (unsigned)(sr * cur.kp + sc); SLOAD_H((const bf16*)(wsb + cur.k), (const bf16*)(wsb + cur.k + VOFF), kb0, cur.kp, lo); } VMW(); SWRITE_HK(0);
    __syncthreads();
}
__device__ __forceinline__ void swa_block(unsigned char* wsb, const BlockRef& cur, const BlockRef& nxt, char* lds, Seam& S, const int tid) {
    const int wid = __builtin_amdgcn_readfirstlane(tid >> 6), lane = tid & 63, r32 = lane & 31, hi = lane >> 5;
    constexpr int W = WIN;
    const int j_lo = swa_jlo(cur.P0);
    int j_hi = (cur.P0 + QB - 1) / KVBLK + 1; if (j_hi > cur.skv / KVBLK) j_hi = cur.skv / KVBLK;
    const int NT = j_hi - j_lo;
    const int kbn = swa_jlo(nxt.P0) * KVBLK;
    const int qlo = cur.P0 + wid * QBLK, qm = qlo + r32 - 4 * hi;
    char* V_lds = lds; char* K_lds = lds + 2 * SHM_V;
    float* ws = (float*)(lds + 2 * SHM_V + 2 * SHM_K) + wid * 64; float* li_l = ws, * al_l = ws + 32;
    float m_reg = -1e30f, l_reg = 0; f32x16 o[4] = {};
    const int sr = tid >> 4, sc = (tid & 15) * 8, vst0 = v_st(sr, sc), vst1 = v_st(32 + sr, sc), kws = KSWZ(sr, sc * 2);
    const int vb0 = (int)(uintptr_t)V_lds + v_rd_base(lane);
    const bf16* Kh = (const bf16*)(wsb + cur.k); const bf16* Vh = (const bf16*)(wsb + cur.k + VOFF); const int kp = cur.kp; const unsigned slo = (unsigned)(sr * kp + sc);
#define RESC(a) do { if (__any((a) < 1.f)) { if (hi == 0) al_l[r32] = (a); asm volatile("s_waitcnt lgkmcnt(0)" ::: "memory");              \
                     for (int d_ = 0; d_ < 4; ++d_) for (int r = 0; r < 16; ++r) o[d_][r] *= al_l[crow(r, hi)]; } } while (0)
#define KBASE(t) ((j_lo + (t)) * KVBLK)
#define ACT(t) (KBASE(t) <= qlo + QBLK - 1 && KBASE(t) + KVBLK - 1 >= qlo - W + 1)
#define MASKT(P0_, P1_, t) do { const int kb_ = KBASE(t); if ((!SK || ACT(t)) && (kb_ + KVBLK - 1 > qlo || kb_ <= qlo + QBLK - 1 - W)) mask_tile(P0_, P1_, qm - kb_, (unsigned)W); } while (0)
    constexpr int NQL = 8;
    constexpr bool SK = WSKIP;
#define SEAM_K0() do { VMWN(NQL); SWRITE_HK(0); SBAR(); } while (0)
    f32x16 pA0, pA1, pB0, pB1; float mnA, mnB, alA, alB; bf16x8 pa0, pa1, pa2, pa3;
    SWRITE_HV(0); SBAR();
    if (NT > 1) { SLOAD_H(Kh, Vh, KBASE(1), kp, slo); }
    SBAR(); qkt<0, SK>(pA0, pA1, K_lds, r32, hi, S.qr, ACT(0));
    MASKT(pA0, pA1, 0); partialSM(pA0, pA1, m_reg, mnA, alA);
    if (NT > 1) { VMW(); SWRITE_H(1); }
    __syncthreads();
#define HALF_STEP(PX0, PX1, mnX, alX, PY0, PY1, alY, t, KB, VB, SB) do {                                                      \
        SBAR(); qkt<KB, SK>(PX0, PX1, K_lds, r32, hi, S.qr, ACT(t));                                             \
        finishSM(PY0, PY1, alY, l_reg, pa0, pa1, pa2, pa3); SBAR();                                                           \
        if ((t) + 1 < NT) { SLOAD_H(Kh, Vh, KBASE((t) + 1), kp, slo); SBAR(); }                                               \
        pv_tile<VB, SK>(o, vb0, pa0, pa1, pa2, pa3, ACT((t) - 1)); MASKT(PX0, PX1, (t)); partialSM(PX0, PX1, m_reg, mnX, alX);                                        \
        __syncthreads();                                                                                                      \
        if ((t) + 1 < NT) { VMW(); SWRITE_H(SB); }                                                                          \
        RESC(alX); __syncthreads(); } while (0)
    for (int t = 1; t + 1 < NT; t += 2) {
        HALF_STEP(pB0, pB1, mnB, alB, pA0, pA1, alA, t, 1, 0, 0);
        HALF_STEP(pA0, pA1, mnA, alA, pB0, pB1, alB, t + 1, 0, 1, 1);
    }
    const bool even = (NT & 1) == 0;
    if (even) { SBAR(); qkt<1, SK>(pB0, pB1, K_lds, r32, hi, S.qr, ACT(NT - 1)); SBAR(); }
    { const unsigned nlo = (unsigned)(sr * nxt.kp + sc); SLOAD_H((const bf16*)(wsb + nxt.k), (const bf16*)(wsb + nxt.k + VOFF), kbn, nxt.kp, nlo); SBAR();
      const unsigned qlo = (unsigned)((wid * QBLK + r32) * nxt.qp + hi * 8); const bf16* qb_ = (const bf16*)(wsb + nxt.q);
#pragma unroll
        for (int d0 = 0; d0 < 8; ++d0) S.qr[d0] = load8((qb_ + qlo) + d0 * 16); }
    SBAR();
    finishSM(pA0, pA1, alA, l_reg, pa0, pa1, pa2, pa3); SBAR();
    pv_tile<0, SK>(o, vb0, pa0, pa1, pa2, pa3, ACT(even ? NT - 2 : NT - 1));
    if (even) { MASKT(pB0, pB1, NT - 1); partialSM(pB0, pB1, m_reg, mnB, alB); __syncthreads(); RESC(alB);
        finishSM(pB0, pB1, alB, l_reg, pa0, pa1, pa2, pa3); SBAR(); pv_tile<1, SK>(o, vb0, pa0, pa1, pa2, pa3, ACT(NT - 1)); }
    SBAR(); SEAM_K0();
    if (hi == 0) { li_l[r32] = l_reg; ((float*)(wsb + cur.l))[(size_t)(wid * QBLK + r32) * (cur.kp >> 7)] = m_reg * SCALE + __logf(l_reg); }
    asm volatile("s_waitcnt lgkmcnt(0)" ::: "memory");
    float rli[16];
#pragma unroll
    for (int r = 0; r < 16; ++r) rli[r] = __builtin_amdgcn_rcpf(li_l[crow(r, hi)]);
    bf16* Ow = (bf16*)(wsb + cur.o) + (size_t)(wid * QBLK) * cur.kp; const unsigned olo = (unsigned)(4 * hi * cur.kp + r32);
#pragma unroll
    for (int r = 0; r < 16; ++r) { bf16* Or = Ow + (size_t)((r & 3) + 8 * (r >> 2)) * cur.kp;
#pragma unroll
        for (int d0 = 0; d0 < 4; ++d0) { const float v = o[d0][r] * rli[r];
            const float vn = __shfl_xor(v, 1);
            if ((r32 & 1) == 0) *(unsigned*)((Or + olo) + d0 * 32) = cvtpk(v, vn); } }
    __syncthreads();
#undef RESC
#undef KBASE
#undef ACT
#undef MASKT
#undef SEAM_K0
#undef HALF_STEP
}
#undef ROW
#undef VMW
#undef VMWN
#undef SLOAD_H
#undef SWRITE_HK
#undef SWRITE_HV
#undef SWRITE_H
#undef KSWZ
#undef SBAR
}
namespace chain {
typedef short bf16x8 __attribute__((ext_vector_type(8)));
typedef short s16x4 __attribute__((ext_vector_type(4)));
typedef float f32x4 __attribute__((ext_vector_type(4)));
typedef float f32x2 __attribute__((ext_vector_type(2)));
typedef unsigned u32x4 __attribute__((ext_vector_type(4)));
typedef unsigned u32x2 __attribute__((ext_vector_type(2)));
typedef __bf16 bf2_t __attribute__((ext_vector_type(2)));
#define CH_LAS __attribute__((address_space(3)))
constexpr int KC_OFF = 0, VTP_OFF = 65536, VRT_OFF = VTP_OFF + 12288, CS_OFF = VRT_OFF + 12288, GT_OFF = CS_OFF + 24576;
constexpr int CHAIN_LDS = GT_OFF + 4 * 512;
static_assert(CHAIN_LDS <= 131072, "chain LDS map");
__device__ __forceinline__ unsigned off_b(unsigned row, unsigned ch) { return 256u * row + 16u * (ch ^ (((row & 3) << 2) | ((row >> 2) & 3))); }
__device__ __forceinline__ unsigned pk_bf16(float lo, float hi) { bf2_t v = {(__bf16)lo, (__bf16)hi}; return __builtin_bit_cast(unsigned, v); }
__device__ __forceinline__ float bflo(unsigned w) { return __uint_as_float(w << 16); }
__device__ __forceinline__ float bfhi(unsigned w) { return __uint_as_float(w & 0xffff0000u); }
__device__ __forceinline__ float wave_incl_sum(float v, int lane) {
#pragma unroll
    for (int o = 1; o < 64; o <<= 1) { const float t = __shfl_up(v, o); if (lane >= o) v += t; }
    return v;
}
__device__ __forceinline__ float wave_incl_max(float v, int lane) {
#pragma unroll
    for (int o = 1; o < 64; o <<= 1) { const float t = __shfl_up(v, o); if (lane >= o) v = fmaxf(v, t); }
    return v;
}
__device__ __forceinline__ unsigned vt_off(unsigned dd, unsigned c16) { return dd * 256u + ((c16 ^ (dd & 15u)) << 4); }
__device__ __forceinline__ unsigned cs_off(unsigned dd, unsigned c32) { return dd * 512u + ((c32 ^ (dd & 15u)) << 4); }

__device__ __forceinline__ void run_chain(unsigned char* ws, CH_LAS unsigned char* lds, const int ch, const int half, const int tid) {
    const int w = __builtin_amdgcn_readfirstlane(tid >> 6), lane = tid & 63, g = lane >> 4, i16 = lane & 15;
    const int tw = (w < 4) ? w : 11 - w;
    const int bl = ch >> 5, h = (ch >> 3) & 3, ds = ch & 7;
    const unsigned short* QM = (const unsigned short*)(ws + WS_QM); const unsigned short* KM = (const unsigned short*)(ws + WS_KM); const unsigned short* VM = (const unsigned short*)(ws + WS_VM);
    const unsigned short* OM = (const unsigned short*)(ws + WS_OM); unsigned short* Y = (unsigned short*)(ws + WS_Y);
    const float* gli = (const float*)(ws + WS_GATES); const float* glf = gli + (size_t)TT * 4;
    CH_LAS float* GU = (CH_LAS float*)(lds + GT_OFF); CH_LAS float* GM_ = GU + 128; CH_LAS float* GW = GU + 256; CH_LAS float* GF = GU + 384;
    for (int i = tid; i < (48 * 256) / 4; i += 512) { const int row = i >> 6; ((CH_LAS unsigned*)(lds + VTP_OFF))[i] = (row == 32) ? 0x3F803F80u : 0u; ((CH_LAS unsigned*)(lds + VRT_OFF))[i] = 0u; }
    for (int i = tid; i < (48 * 512) / 4; i += 512) ((CH_LAS unsigned*)(lds + CS_OFF))[i] = 0u;
    f32x4 cst[2][3];
#pragma unroll
    for (int a = 0; a < 2; ++a)
#pragma unroll
        for (int n = 0; n < 3; ++n) cst[a][n] = (f32x4){0.f, 0.f, 0.f, 0.f};
    float m_prev = 0.f;
    const size_t rowb = (size_t)bl * SEQ;
    const int ecol = h * 256;
    __syncthreads();
    for (int c = 0; c < SEQ / 128; ++c) {
        const size_t r0 = rowb + (size_t)c * 128;
        u32x4 kst[8];
#pragma unroll
        for (int i = 0; i < 8; ++i) { const int p = tid + 512 * i, s = p >> 5, c32 = p & 31; kst[i] = *(const u32x4*)(KM + (r0 + s) * 1024 + ecol + c32 * 8); }
        bf16x8 qf[8];
#pragma unroll
        for (int kk = 0; kk < 8; ++kk) qf[kk] = *(const bf16x8*)(QM + (r0 + 16 * tw + i16) * 1024 + ecol + 32 * kk + 8 * g);
        const int vs = tid >> 2, vp = tid & 3;
        const u32x4 vst = *(const u32x4*)(VM + (r0 + vs) * 1024 + ecol + ds * 32 + vp * 8);
        const size_t R0 = (size_t)half * TH + r0;
        const float li0 = gli[(R0 + 2 * lane) * 4 + h], li1 = gli[(R0 + 2 * lane + 1) * 4 + h], lf0 = glf[(R0 + 2 * lane) * 4 + h], lf1 = glf[(R0 + 2 * lane + 1) * 4 + h];
        unsigned short omv[2][4];
#pragma unroll
        for (int n = 0; n < 2; ++n)
#pragma unroll
            for (int rg = 0; rg < 4; ++rg) omv[n][rg] = OM[(r0 + 16 * tw + 4 * g + rg) * 1024 + ecol + ds * 32 + 16 * n + i16];
        const float c1 = lf0 + lf1, incl = wave_incl_sum(c1, lane), b1 = incl, b0 = incl - lf1;
        const float u0 = li0 - b0, u1 = li1 - b1;
        const float im = wave_incl_max(fmaxf(u0, u1), lane); float em = __shfl_up(im, 1); if (lane == 0) em = -3.0e38f;
        const float M0 = fmaxf(m_prev, fmaxf(em, u0)), M1 = fmaxf(m_prev, im);
        const float Mlast = __shfl(M1, 63), blast = __shfl(b1, 63);
        const float rr0 = __expf(u0 - Mlast), rr1 = __expf(u1 - Mlast), decay = __expf(m_prev - Mlast);
        if (w == 0) { *(CH_LAS f32x2*)(GU + 2 * lane) = (f32x2){u0, u1}; *(CH_LAS f32x2*)(GM_ + 2 * lane) = (f32x2){M0, M1};
            *(CH_LAS f32x2*)(GW + 2 * lane) = (f32x2){__expf(m_prev - M0), __expf(m_prev - M1)}; *(CH_LAS f32x2*)(GF + 2 * lane) = (f32x2){__expf(-(b0 + M0)), __expf(-(b1 + M1))}; }
        if (w == 1) { *(CH_LAS unsigned*)(lds + VRT_OFF + vt_off(32, (2 * lane) >> 3) + ((2 * lane) & 7) * 2) = pk_bf16(rr0, rr1); }
#pragma unroll
        for (int i = 0; i < 8; ++i) { const int p = tid + 512 * i, s = p >> 5, c32 = p & 31; *(CH_LAS u32x4*)(lds + KC_OFF + (c32 >> 4) * 32768 + off_b(s, c32 & 15)) = kst[i]; }
        { const float ra = __shfl(rr0, vs >> 1), rb = __shfl(rr1, vs >> 1); const float rs = (vs & 1) ? rb : ra;
          const unsigned vw[4] = {vst.x, vst.y, vst.z, vst.w};
          const int kk2 = vs >> 5, a2 = (vs >> 4) & 1, g2 = (vs >> 2) & 3, c2 = vs & 3, pos = 32 * kk2 + 8 * g2 + 4 * a2 + c2;
#pragma unroll
          for (int j = 0; j < 8; ++j) { const int dd = vp * 8 + j; const float v = (j & 1) ? bfhi(vw[j >> 1]) : bflo(vw[j >> 1]);
              *(CH_LAS unsigned short*)(lds + VTP_OFF + vt_off(dd, pos >> 3) + (pos & 7) * 2) = (unsigned short)((j & 1) ? (vw[j >> 1] >> 16) : (vw[j >> 1] & 0xffffu));
              *(CH_LAS unsigned short*)(lds + VRT_OFF + vt_off(dd, vs >> 3) + (vs & 7) * 2) = (unsigned short)(pk_bf16(v * rs, 0.f) & 0xffffu); } }
        f32x4 acc2[3];
#pragma unroll
        for (int n = 0; n < 3; ++n) acc2[n] = (f32x4){0.f, 0.f, 0.f, 0.f};
#pragma unroll
        for (int kk = 0; kk < 8; ++kk)
#pragma unroll
            for (int n = 0; n < 3; ++n) { const bf16x8 cf = *(const CH_LAS bf16x8*)(lds + CS_OFF + cs_off(16 * n + i16, 4 * kk + g)); acc2[n] = __builtin_amdgcn_mfma_f32_16x16x32_bf16(qf[kk], cf, acc2[n], 0, 0, 0); }
        __syncthreads();
        { const f32x4 wi = *(const CH_LAS f32x4*)(GW + 16 * tw + 4 * g);
#pragma unroll
          for (int n = 0; n < 3; ++n) acc2[n] = acc2[n] * wi; }
        const float Mt = GM_[16 * tw + i16];
#pragma unroll
        for (int kp = 0; kp < 4; ++kp) {
            if (2 * kp <= tw) {
                unsigned pw[4];
#pragma unroll
                for (int a = 0; a < 2; ++a) { const int j = 2 * kp + a;
                    if (j <= tw) {
                        f32x4 sacc = (f32x4){0.f, 0.f, 0.f, 0.f};
#pragma unroll
                        for (int kk = 0; kk < 8; ++kk) { const bf16x8 kf = *(const CH_LAS bf16x8*)(lds + KC_OFF + (kk >> 2) * 32768 + off_b(16 * j + i16, 4 * (kk & 3) + g)); sacc = __builtin_amdgcn_mfma_f32_16x16x32_bf16(kf, qf[kk], sacc, 0, 0, 0); }
                        const f32x4 us = *(const CH_LAS f32x4*)(GU + 16 * j + 4 * g);
                        float pv[4];
#pragma unroll
                        for (int rg = 0; rg < 4; ++rg) { float p = sacc[rg] * __expf(us[rg] - Mt); if (j == tw && (4 * g + rg) > i16) p = 0.f; pv[rg] = p; }
                        pw[2 * a] = pk_bf16(pv[0], pv[1]); pw[2 * a + 1] = pk_bf16(pv[2], pv[3]);
                    } else { pw[2 * a] = 0u; pw[2 * a + 1] = 0u; }
                }
                const u32x4 pwv = {pw[0], pw[1], pw[2], pw[3]}; const bf16x8 pf = __builtin_bit_cast(bf16x8, pwv);
#pragma unroll
                for (int n = 0; n < 3; ++n) { const bf16x8 vf = *(const CH_LAS bf16x8*)(lds + VTP_OFF + vt_off(16 * n + i16, 4 * kp + g)); acc2[n] = __builtin_amdgcn_mfma_f32_16x16x32_bf16(pf, vf, acc2[n], 0, 0, 0); }
            }
        }
        { const f32x4 fl = *(const CH_LAS f32x4*)(GF + 16 * tw + 4 * g);
#pragma unroll
          for (int rg = 0; rg < 4; ++rg) { const float den = __shfl(acc2[2][rg], 16 * g); const float inv = 1.0f / fmaxf(fabsf(den), fl[rg]);
#pragma unroll
              for (int n = 0; n < 2; ++n) { const float yv = acc2[n][rg] * inv * __uint_as_float(((unsigned)omv[n][rg]) << 16);
                  Y[(r0 + 16 * tw + 4 * g + rg) * 1024 + ecol + ds * 32 + 16 * n + i16] = (unsigned short)(pk_bf16(yv, 0.f) & 0xffffu); } } }
#pragma unroll
        for (int a = 0; a < 2; ++a)
#pragma unroll
            for (int n = 0; n < 3; ++n) cst[a][n] = cst[a][n] * decay;
#pragma unroll
        for (int kp = 0; kp < 4; ++kp) {
            bf16x8 vr[3];
#pragma unroll
            for (int n = 0; n < 3; ++n) vr[n] = *(const CH_LAS bf16x8*)(lds + VRT_OFF + vt_off(16 * n + i16, 4 * kp + g));
#pragma unroll
            for (int a = 0; a < 2; ++a) { const unsigned cc = (unsigned)((2 * w + a) & 7), eh = (unsigned)(w >> 2), q4 = (unsigned)(i16 >> 2), p4 = (unsigned)(i16 & 3);
                const unsigned ad0 = KC_OFF + eh * 32768u + off_b(32 * kp + 8 * g + q4, 2 * cc + (p4 >> 1)) + 8 * (p4 & 1);
                const unsigned ad1 = KC_OFF + eh * 32768u + off_b(32 * kp + 8 * g + 4 + q4, 2 * cc + (p4 >> 1)) + 8 * (p4 & 1);
                const s16x4 lo = __builtin_amdgcn_ds_read_tr16_b64_v4i16((CH_LAS s16x4*)(lds + ad0)), hi = __builtin_amdgcn_ds_read_tr16_b64_v4i16((CH_LAS s16x4*)(lds + ad1));
                const bf16x8 kt = __builtin_shufflevector(lo, hi, 0, 1, 2, 3, 4, 5, 6, 7);
#pragma unroll
                for (int n = 0; n < 3; ++n) cst[a][n] = __builtin_amdgcn_mfma_f32_16x16x32_bf16(kt, vr[n], cst[a][n], 0, 0, 0); }
        }
#pragma unroll
        for (int a = 0; a < 2; ++a)
#pragma unroll
            for (int n = 0; n < 3; ++n) { const unsigned dd = 16 * n + i16, e = 32 * w + 16 * a + 4 * g; u32x2 o; o.x = pk_bf16(cst[a][n][0], cst[a][n][1]); o.y = pk_bf16(cst[a][n][2], cst[a][n][3]);
                *(CH_LAS u32x2*)(lds + CS_OFF + cs_off(dd, e >> 3) + (e & 7) * 2) = o; }
        m_prev = blast + Mlast;
        __syncthreads();
    }
}
#undef CH_LAS
}
__device__ __forceinline__ int win_dest_row(int n) {
    if (n >= 2048) return n;
    const int n256 = n & 255, base = n - n256, hl = n256 >> 7, e = n256 & 127, bj = e >> 6;
    return base + 128 * bj + hl * 64 + (e & 63);
}
template <bool PERMUTE>
__device__ __forceinline__ void p0_transpose_item(const float* W, int K, int N, bf16* WT, int row_off, LAS float* scr, int item, int lane) {
    const int nblk = N / 32, kb = item / nblk, nb = item % nblk, k0 = 64 * kb, n0 = 32 * nb;
#pragma unroll 8
    for (int i = 0; i < 32; ++i) { const int kk = 2 * i + (lane >> 5); scr[kk * 33 + (lane & 31)] = W[(size_t)(k0 + kk) * N + n0 + (lane & 31)]; }
    LDS_WAIT(); asm volatile("" ::: "memory");
    const int c = lane & 7;
#pragma unroll
    for (int j = 0; j < 4; ++j) { const int n = (lane >> 3) + 8 * j; const LAS float* s = scr + (8 * c) * 33 + n;
        v4u o; o.x = pk2(s[0 * 33], s[1 * 33]); o.y = pk2(s[2 * 33], s[3 * 33]); o.z = pk2(s[4 * 33], s[5 * 33]); o.w = pk2(s[6 * 33], s[7 * 33]);
        const int dr = row_off + (PERMUTE ? win_dest_row(n0 + n) : (n0 + n));
        *(GAS v4u*)(WT + (size_t)dr * K + k0 + 8 * c) = o; }
    LDS_WAIT(); asm volatile("" ::: "memory");
}
struct RopeTab { double inv2pi[64]; };
__device__ __forceinline__ void p0a_prologue(Frame& F, const float* I_c, const float* I_w_ada, const float* I_b_ada, const float* I_w_in, const float* I_w_qm, const float* I_w_km, const float* I_w_vm, const float* I_w_if,
                                             const float* I_w_pa, const float* I_w_pm, const float* I_w_out, const int* I_pos, const double* inv2pi, int bid) {
    const int gtid = F.vcu * 512 + F.tid, NT = F.G * 512;
    {
        LAS float* sc = (LAS float*)(F.lds + RING_OFF);
        LAS float* red = (LAS float*)(F.lds + RING_OFF + 32768);
        float* ada = (float*)(F.ws + WS_ADA);
        if ((int)bid < 192) {
            for (int i = F.tid; i < 8192; i += 512) { const float v = I_c[i]; sc[i] = v / (1.0f + expf(-v)); }
            __syncthreads();
            for (int cb = bid; cb < 192; cb += F.G) {
                const int col = F.tid & 15, ks = F.tid >> 4;
                float a[8];
#pragma unroll
                for (int b = 0; b < 8; ++b) a[b] = 0.f;
                for (int kk = 0; kk < 32; ++kk) { const int k = ks * 32 + kk; const float w = I_w_ada[(size_t)k * 3072 + cb * 16 + col];
#pragma unroll
                    for (int b = 0; b < 8; ++b) a[b] += sc[b * 1024 + k] * w; }
#pragma unroll
                for (int b = 0; b < 8; ++b) red[(ks * 16 + col) * 8 + b] = a[b];
                __syncthreads();
                if (F.tid < 128) { const int c2 = F.tid & 15, b = F.tid >> 4; float s = 0.f; for (int k2 = 0; k2 < 32; ++k2) s += red[(k2 * 16 + c2) * 8 + b]; ada[b * 3072 + cb * 16 + c2] = s + I_b_ada[cb * 16 + c2]; }
                __syncthreads();
            }
        }
        __syncthreads();
    }
    {
        LAS float* scr = (LAS float*)(F.lds + RING_OFF + F.wave * 16384);
        const int gw = F.vcu * NWAVES + F.wave, NGW = F.G * NWAVES;
        constexpr int I_IN = (1024 / 64) * (8192 / 32), I_PA = (512 / 64) * (1024 / 32), I_PM = (1024 / 64) * (1024 / 32), I_OUT = I_PM, I_H = (256 / 64) * (256 / 32);
        constexpr int NITEMS = I_IN + I_PA + I_PM + I_OUT + 12 * I_H;
        bf16* WIN = (bf16*)(F.ws + WS_WIN); bf16* WPA = (bf16*)(F.ws + WS_WPA); bf16* WPM = (bf16*)(F.ws + WS_WPM); bf16* WOUT = (bf16*)(F.ws + WS_WOUT); bf16* WQKV = (bf16*)(F.ws + WS_WQKV);
        for (int it = gw; it < NITEMS; it += NGW) {
            int r = it;
            if (r < I_IN) { p0_transpose_item<true>(I_w_in, 1024, 8192, WIN, 0, scr, r, F.lane); continue; } r -= I_IN;
            if (r < I_PA) { p0_transpose_item<false>(I_w_pa, 512, 1024, WPA, 0, scr, r, F.lane); continue; } r -= I_PA;
            if (r < I_PM) { p0_transpose_item<false>(I_w_pm, 1024, 1024, WPM, 0, scr, r, F.lane); continue; } r -= I_PM;
            if (r < I_OUT) { p0_transpose_item<false>(I_w_out, 1024, 1024, WOUT, 0, scr, r, F.lane); continue; } r -= I_OUT;
            const int wh = r / I_H, ri = r % I_H, which = wh >> 2, head = wh & 3;
            const float* W = (which == 0 ? I_w_qm : (which == 1 ? I_w_km : I_w_vm)) + (size_t)head * 65536;
            p0_transpose_item<false>(W, 256, 256, WQKV, wh * 256, scr, ri, F.lane);
        }
    }
    {
        float* rope = (float*)(F.ws + WS_ROPE);
        for (int i = gtid; i < TT * 64; i += NT) { const int t = i >> 6, e = i & 63; double a = (double)I_pos[t] * inv2pi[e]; a -= __builtin_rint(a);
            const float ang = (float)a * 6.283185307179586f; f32x2 cs; cs.x = cosf(ang); cs.y = sinf(ang); *(f32x2*)(rope + (size_t)i * 2) = cs; }
    }
    {
        float* gwp = (float*)(F.ws + WS_GW);
        for (int i = gtid; i < 16384; i += NT) { const int which = i >> 13, c = (i >> 3) & 1023, j = i & 7, h = c >> 8;
            float s = 0.f;
            if (which == 0) { const float* wq = I_w_qm + (size_t)c * 256; const float* wk = I_w_km + (size_t)c * 256; float sq = 0.f, sk = 0.f;
                for (int e = 0; e < 256; ++e) { sq += wq[e] * I_w_if[(size_t)(h * 256 + e) * 8 + j]; sk += wk[e] * I_w_if[(size_t)(1024 + h * 256 + e) * 8 + j]; }
                s = sq + 0.0625f * sk; }
            else { const float* wv = I_w_vm + (size_t)c * 256; for (int e = 0; e < 256; ++e) s += wv[e] * I_w_if[(size_t)(2048 + h * 256 + e) * 8 + j]; }
            gwp[i] = s; }
    }
}
__device__ __forceinline__ bf16* h_row_ptr(Frame& F, int R) { return (bf16*)((unsigned char*)F.out + (size_t)(R / TH) * (64 * MiB)) + (size_t)(R % TH) * DM; }
__device__ __forceinline__ void p0b_lnmod(Frame& F, const float* x) {
    const int gw = F.vcu * NWAVES + F.wave, NGW = F.G * NWAVES;
    const float* ada = (const float*)(F.ws + WS_ADA);
    for (int R = gw; R < TT; R += NGW) {
        const GAS f32x4* xr = (const GAS f32x4*)(x + (size_t)R * DM) + F.lane;
        f32x4 v[4]; float s = 0.f;
#pragma unroll
        for (int j = 0; j < 4; ++j) { v[j] = xr[64 * j]; s += (v[j].x + v[j].y) + (v[j].z + v[j].w); }
        const float mean = wave_sum(s) * (1.f / DM); float s2 = 0.f;
#pragma unroll
        for (int j = 0; j < 4; ++j) { v[j] = v[j] - mean; s2 += (v[j].x * v[j].x + v[j].y * v[j].y) + (v[j].z * v[j].z + v[j].w * v[j].w); }
        const float rstd = 1.f / sqrtf(wave_sum(s2) * (1.f / DM) + LN_EPS);
        const int b = R >> 12; const f32x4* sh = (const f32x4*)(ada + (size_t)b * 3072) + F.lane; const f32x4* sc = (const f32x4*)(ada + (size_t)b * 3072 + 1024) + F.lane;
        GAS unsigned long long* o8 = (GAS unsigned long long*)h_row_ptr(F, R) + F.lane;
#pragma unroll
        for (int j = 0; j < 4; ++j) { const f32x4 a = sh[64 * j], m = sc[64 * j]; const f32x4 y = v[j] * rstd * (m + 1.0f) + a;
            o8[64 * j] = (unsigned long long)pk2(y.x, y.y) | ((unsigned long long)pk2(y.z, y.w) << 32); }
    }
}
__device__ __forceinline__ float logsigmoidf(float x) { return fminf(x, 0.f) - log1pf(expf(-fabsf(x))); }
__device__ __forceinline__ void p2a_conv(Frame& F, int half, const float* conv_w, const float* conv_b, const float* b_if, int bid) {
    const bf16* XM = (const bf16*)(F.ws + WS_XM); bf16* XC = (bf16*)(F.ws + WS_XC);
    float* gli = (float*)(F.ws + WS_GATES); float* glf = gli + (size_t)TT * 4;
    const float* gwp = (const float*)(F.ws + WS_GW);
    LAS float* red = (LAS float*)(F.lds + RING_OFF);
    const int cg = F.tid & 255, grp = F.tid >> 8, c0 = 4 * cg;
    float cw[4][4], cb[4], ga[4][8], gb[4][8];
#pragma unroll
    for (int j = 0; j < 4; ++j) { const f32x4 w = *(const f32x4*)(conv_w + j * 1024 + c0); cw[j][0] = w.x; cw[j][1] = w.y; cw[j][2] = w.z; cw[j][3] = w.w; }
    { const f32x4 w = *(const f32x4*)(conv_b + c0); cb[0] = w.x; cb[1] = w.y; cb[2] = w.z; cb[3] = w.w; }
#pragma unroll
    for (int ch = 0; ch < 4; ++ch)
#pragma unroll
        for (int j = 0; j < 8; ++j) { ga[ch][j] = gwp[(c0 + ch) * 8 + j]; gb[ch][j] = gwp[8192 + (c0 + ch) * 8 + j]; }
    for (int item = bid; item < TH / 64; item += F.G) {
        const int r0 = item * 64 + grp * 32; const int s0 = (half * TH + r0) & (SEQ - 1);
        float h1[4], h2[4], h3[4];
        if (s0 == 0) {
#pragma unroll
            for (int ch = 0; ch < 4; ++ch) { h1[ch] = 0.f; h2[ch] = 0.f; h3[ch] = 0.f; }
        } else {
            const v2u a1 = *(const v2u*)(XM + (size_t)(r0 - 1) * 1024 + c0), a2 = *(const v2u*)(XM + (size_t)(r0 - 2) * 1024 + c0), a3 = *(const v2u*)(XM + (size_t)(r0 - 3) * 1024 + c0);
            h1[0] = bflo(a1.x); h1[1] = bfhi(a1.x); h1[2] = bflo(a1.y); h1[3] = bfhi(a1.y);
            h2[0] = bflo(a2.x); h2[1] = bfhi(a2.x); h2[2] = bflo(a2.y); h2[3] = bfhi(a2.y);
            h3[0] = bflo(a3.x); h3[1] = bfhi(a3.x); h3[2] = bflo(a3.y); h3[3] = bfhi(a3.y);
        }
        for (int bt = 0; bt < 4; ++bt) {
            float acc[64];
#pragma unroll
            for (int i = 0; i < 64; ++i) acc[i] = 0.f;
#pragma unroll
            for (int tk = 0; tk < 8; ++tk) {
                const int r = r0 + bt * 8 + tk;
                const v2u xw = *(const v2u*)(XM + (size_t)r * 1024 + c0);
                float xv[4] = {bflo(xw.x), bfhi(xw.x), bflo(xw.y), bfhi(xw.y)}, xc[4];
#pragma unroll
                for (int ch = 0; ch < 4; ++ch) { const float pre = cb[ch] + cw[0][ch] * h3[ch] + cw[1][ch] * h2[ch] + cw[2][ch] * h1[ch] + cw[3][ch] * xv[ch];
                    xc[ch] = pre / (1.0f + __expf(-pre)); h3[ch] = h2[ch]; h2[ch] = h1[ch]; h1[ch] = xv[ch]; }
                v2u ow; ow.x = pk2(xc[0], xc[1]); ow.y = pk2(xc[2], xc[3]);
                *(v2u*)(XC + (size_t)r * 1024 + c0) = ow;
#pragma unroll
                for (int j = 0; j < 8; ++j) { float s = 0.f;
#pragma unroll
                    for (int ch = 0; ch < 4; ++ch) s += xc[ch] * ga[ch][j] + xv[ch] * gb[ch][j];
                    acc[tk * 8 + j] = s; }
            }
#define RS_STEP(H) { const bool up = (F.lane & (H)) != 0; _Pragma("unroll") for (int i = 0; i < (H); ++i) { const float a = acc[i], b = acc[i + (H)]; const float keep = up ? b : a, send = up ? a : b; acc[i] = keep + __shfl_xor(send, (H)); } }
            RS_STEP(32) RS_STEP(16) RS_STEP(8) RS_STEP(4) RS_STEP(2) RS_STEP(1)
#undef RS_STEP
            red[F.wave * 64 + F.lane] = acc[0];
            __syncthreads();
            if ((F.wave & 3) == 0) { const int wb = F.wave * 64 + F.lane; const float v = (red[wb] + red[wb + 64]) + (red[wb + 128] + red[wb + 192]);
                const int tk = F.lane >> 3, j = F.lane & 7; const size_t R = (size_t)half * TH + r0 + bt * 8 + tk; const float g = v + b_if[j];
                if (j < 4) gli[R * 4 + j] = g; else glf[R * 4 + (j - 4)] = logsigmoidf(g); }
            __syncthreads();
        }
    }
}
__device__ __forceinline__ void p3_attention_simple(Frame& F, int half) {
    const bf16* QA = (const bf16*)(F.ws + WS_QA); const bf16* KA = (const bf16*)(F.ws + WS_KA); const bf16* VA = (const bf16*)(F.ws + WS_VA); const bf16* ZA = (const bf16*)(F.ws + WS_ZA);
    bf16* ATG = (bf16*)(F.ws + WS_OG);
    const int gw = F.vcu * NWAVES + F.wave, NGW = F.G * NWAVES, d = 2 * F.lane;
    for (int item = gw; item < TH * 4; item += NGW) {
        const int r = item >> 2, h = item & 3, s = (half * TH + r) & (SEQ - 1);
        float m = -1e30f, l = 0.f, o0 = 0.f, o1 = 0.f;
        for (int g = 0; g < 3; ++g) { const int dil = 1 << (2 * g);
            const unsigned qw = *(const unsigned*)(QA + (size_t)r * 1536 + (g * 4 + h) * 128 + d); const float q0 = bflo(qw), q1 = bfhi(qw);
            int nk = s / dil; if (nk > 128) nk = 128;
            for (int j = 0; j <= nk; ++j) { const size_t rk = (size_t)(r - j * dil);
                const unsigned kw = *(const unsigned*)(KA + rk * 512 + h * 128 + d); const unsigned vw = *(const unsigned*)(VA + rk * 512 + h * 128 + d);
                const float dot = wave_sum(q0 * bflo(kw) + q1 * bfhi(kw)) * ATT_SCALE;
                const float mn = fmaxf(m, dot), al = __expf(m - mn), p = __expf(dot - mn);
                l = l * al + p; o0 = o0 * al + p * bflo(vw); o1 = o1 * al + p * bfhi(vw); m = mn; } }
        const unsigned zw = *(const unsigned*)(ZA + (size_t)r * 512 + h * 128 + d); const float il = 1.0f / l;
        *(unsigned*)(ATG + (size_t)r * 512 + h * 128 + d) = pk2(o0 * il * bflo(zw), o1 * il * bfhi(zw));
    }
}
__device__ __forceinline__ void p3_chain_simple(Frame& F, int half, int bid) {
    const bf16* QM = (const bf16*)(F.ws + WS_QM); const bf16* KM = (const bf16*)(F.ws + WS_KM); const bf16* VM = (const bf16*)(F.ws + WS_VM); const bf16* OM = (const bf16*)(F.ws + WS_OM);
    bf16* Y = (bf16*)(F.ws + WS_Y);
    const float* gli = (const float*)(F.ws + WS_GATES); const float* glf = gli + (size_t)TT * 4;
    const int dd = F.tid >> 4, ec = F.tid & 15;
    for (int ch = bid; ch < 128; ch += F.G) {
        const int bl = ch >> 5, h = (ch >> 3) & 3, ds = ch & 7, c = h * 256 + ds * 32 + dd, eb = h * 256 + ec * 16;
        float C[16], n[16], m = 0.f;
#pragma unroll
        for (int i = 0; i < 16; ++i) { C[i] = 0.f; n[i] = 0.f; }
        for (int t = 0; t < SEQ; ++t) { const size_t r = (size_t)bl * SEQ + t, R = (size_t)half * TH + r;
            const float li = gli[R * 4 + h], lf = glf[R * 4 + h];
            const v4u k0 = *(const v4u*)(KM + r * 1024 + eb), k1 = *(const v4u*)(KM + r * 1024 + eb + 8), q0 = *(const v4u*)(QM + r * 1024 + eb), q1 = *(const v4u*)(QM + r * 1024 + eb + 8);
            const float v = bf2f(VM[r * 1024 + c]);
            const float mn = fmaxf(lf + m, li), fp = __expf(lf + m - mn), ip = __expf(li - mn);
            float kk[16] = {bflo(k0.x), bfhi(k0.x), bflo(k0.y), bfhi(k0.y), bflo(k0.z), bfhi(k0.z), bflo(k0.w), bfhi(k0.w), bflo(k1.x), bfhi(k1.x), bflo(k1.y), bfhi(k1.y), bflo(k1.z), bfhi(k1.z), bflo(k1.w), bfhi(k1.w)};
            float qq[16] = {bflo(q0.x), bfhi(q0.x), bflo(q0.y), bfhi(q0.y), bflo(q0.z), bfhi(q0.z), bflo(q0.w), bfhi(q0.w), bflo(q1.x), bfhi(q1.x), bflo(q1.y), bfhi(q1.y), bflo(q1.z), bfhi(q1.z), bflo(q1.w), bfhi(q1.w)};
            float num = 0.f, den = 0.f; const float iv = ip * v;
#pragma unroll
            for (int i = 0; i < 16; ++i) { C[i] = fp * C[i] + iv * kk[i]; n[i] = fp * n[i] + ip * kk[i]; num += C[i] * qq[i]; den += n[i] * qq[i]; }
#pragma unroll
            for (int o = 1; o < 16; o <<= 1) { num += __shfl_xor(num, o); den += __shfl_xor(den, o); }
            const float hv = num / fmaxf(fabsf(den), __expf(-mn)); m = mn;
            if (ec == 0) Y[r * 1024 + c] = (bf16)f2bf(bf2f(OM[r * 1024 + c]) * hv);
        }
    }
}
template <bool MERGE>
__device__ __forceinline__ void p4a_finalize(Frame& F, int half, const float* mh_norm_w, const float* skip_m) {
    const bf16* Y = (const bf16*)(F.ws + WS_Y); const bf16* XC = (const bf16*)(F.ws + WS_XC); const bf16* ZM = (const bf16*)(F.ws + WS_ZM); bf16* HMG = (bf16*)(F.ws + WS_HMG);
    const bf16* OG = (const bf16*)(F.ws + WS_OG); const bf16* ZA = (const bf16*)(F.ws + WS_ZA); const float* LSE = (const float*)(F.ws + WS_LSE); bf16* ATG = (bf16*)(F.ws + WS_ATG);
    const int gw = F.vcu * NWAVES + F.wave, NGW = F.G * NWAVES, c16 = 16 * F.lane, c8 = 8 * F.lane, hd = F.lane >> 4;
    float nw[16], sk[16];
#pragma unroll
    for (int i = 0; i < 16; ++i) { nw[i] = mh_norm_w[c16 + i]; sk[i] = skip_m[c16 + i]; }
    for (int r = gw; r < TH; r += NGW) {
        { const v4u y0 = *(const v4u*)(Y + (size_t)r * 1024 + c16), y1 = *(const v4u*)(Y + (size_t)r * 1024 + c16 + 8);
          float y[16] = {bflo(y0.x), bfhi(y0.x), bflo(y0.y), bfhi(y0.y), bflo(y0.z), bfhi(y0.z), bflo(y0.w), bfhi(y0.w), bflo(y1.x), bfhi(y1.x), bflo(y1.y), bfhi(y1.y), bflo(y1.z), bfhi(y1.z), bflo(y1.w), bfhi(y1.w)};
          float s = 0.f;
#pragma unroll
          for (int i = 0; i < 16; ++i) s += y[i];
#pragma unroll
          for (int o = 1; o < 16; o <<= 1) s += __shfl_xor(s, o);
          const float mu = s * (1.f / 256.f); float q = 0.f;
#pragma unroll
          for (int i = 0; i < 16; ++i) { y[i] -= mu; q += y[i] * y[i]; }
#pragma unroll
          for (int o = 1; o < 16; o <<= 1) q += __shfl_xor(q, o);
          const float rstd = 1.f / sqrtf(q * (1.f / 256.f) + LN_EPS);
          const v4u x0 = *(const v4u*)(XC + (size_t)r * 1024 + c16), x1 = *(const v4u*)(XC + (size_t)r * 1024 + c16 + 8), z0 = *(const v4u*)(ZM + (size_t)r * 1024 + c16), z1 = *(const v4u*)(ZM + (size_t)r * 1024 + c16 + 8);
          const float xx[16] = {bflo(x0.x), bfhi(x0.x), bflo(x0.y), bfhi(x0.y), bflo(x0.z), bfhi(x0.z), bflo(x0.w), bfhi(x0.w), bflo(x1.x), bfhi(x1.x), bflo(x1.y), bfhi(x1.y), bflo(x1.z), bfhi(x1.z), bflo(x1.w), bfhi(x1.w)};
          const float zz[16] = {bflo(z0.x), bfhi(z0.x), bflo(z0.y), bfhi(z0.y), bflo(z0.z), bfhi(z0.z), bflo(z0.w), bfhi(z0.w), bflo(z1.x), bfhi(z1.x), bflo(z1.y), bfhi(z1.y), bflo(z1.z), bfhi(z1.z), bflo(z1.w), bfhi(z1.w)};
          float o[16];
#pragma unroll
          for (int i = 0; i < 16; ++i) o[i] = (y[i] * rstd * nw[i] + sk[i] * xx[i]) * zz[i];
          v4u w0, w1; w0.x = pk2(o[0], o[1]); w0.y = pk2(o[2], o[3]); w0.z = pk2(o[4], o[5]); w0.w = pk2(o[6], o[7]); w1.x = pk2(o[8], o[9]); w1.y = pk2(o[10], o[11]); w1.z = pk2(o[12], o[13]); w1.w = pk2(o[14], o[15]);
          *(v4u*)(HMG + (size_t)r * 1024 + c16) = w0; *(v4u*)(HMG + (size_t)r * 1024 + c16 + 8) = w1; }
        if constexpr (MERGE) {
            const float l0 = LSE[(size_t)r * 4 + hd], l1 = LSE[(size_t)(TH + r) * 4 + hd], l2 = LSE[(size_t)(2 * TH + r) * 4 + hd];
            const float mx = fmaxf(l0, fmaxf(l1, l2)); float w0 = __expf(l0 - mx), w1 = __expf(l1 - mx), w2 = __expf(l2 - mx); const float iw = 1.f / (w0 + w1 + w2); w0 *= iw; w1 *= iw; w2 *= iw;
            const v4u a = *(const v4u*)(OG + (size_t)r * 512 + c8), b = *(const v4u*)(OG + (size_t)(TH + r) * 512 + c8), c = *(const v4u*)(OG + (size_t)(2 * TH + r) * 512 + c8), z = *(const v4u*)(ZA + (size_t)r * 512 + c8);
            v4u o;
            o.x = pk2((w0 * bflo(a.x) + w1 * bflo(b.x) + w2 * bflo(c.x)) * bflo(z.x), (w0 * bfhi(a.x) + w1 * bfhi(b.x) + w2 * bfhi(c.x)) * bfhi(z.x));
            o.y = pk2((w0 * bflo(a.y) + w1 * bflo(b.y) + w2 * bflo(c.y)) * bflo(z.y), (w0 * bfhi(a.y) + w1 * bfhi(b.y) + w2 * bfhi(c.y)) * bfhi(z.y));
            o.z = pk2((w0 * bflo(a.z) + w1 * bflo(b.z) + w2 * bflo(c.z)) * bflo(z.z), (w0 * bfhi(a.z) + w1 * bfhi(b.z) + w2 * bfhi(c.z)) * bfhi(z.z));
            o.w = pk2((w0 * bflo(a.w) + w1 * bflo(b.w) + w2 * bflo(c.w)) * bflo(z.w), (w0 * bfhi(a.w) + w1 * bfhi(b.w) + w2 * bfhi(c.w)) * bfhi(z.w));
            *(v4u*)(ATG + (size_t)r * 512 + c8) = o;
        }
    }
}
__device__ __forceinline__ void p5b_ln(Frame& F, int half, const float* ln_g, const float* ln_b) {
    const int gw = F.vcu * NWAVES + F.wave, NGW = F.G * NWAVES;
    f32x4 g4[4], b4[4];
#pragma unroll
    for (int j = 0; j < 4; ++j) { g4[j] = ((const f32x4*)ln_g)[F.lane + 64 * j]; b4[j] = ((const f32x4*)ln_b)[F.lane + 64 * j]; }
    for (int r = gw; r < TH; r += NGW) {
        GAS f32x4* xr = (GAS f32x4*)(F.out + ((size_t)half * TH + r) * DM) + F.lane;
        f32x4 v[4]; float s = 0.f;
#pragma unroll
        for (int j = 0; j < 4; ++j) { v[j] = xr[64 * j]; s += (v[j].x + v[j].y) + (v[j].z + v[j].w); }
        const float mean = wave_sum(s) * (1.f / DM); float s2 = 0.f;
#pragma unroll
        for (int j = 0; j < 4; ++j) { v[j] = v[j] - mean; s2 += (v[j].x * v[j].x + v[j].y * v[j].y) + (v[j].z * v[j].z + v[j].w * v[j].w); }
        const float rstd = 1.f / sqrtf(wave_sum(s2) * (1.f / DM) + LN_EPS);
#pragma unroll
        for (int j = 0; j < 4; ++j) xr[64 * j] = v[j] * rstd * g4[j] + b4[j];
    }
}

__device__ __forceinline__ swa::BlockRef att_ref(int L) {
    const int bh = L / 48, u = L - bh * 48, g = u >> 4, i = u & 15, bl = bh >> 2, h = bh & 3, d = 1 << (2 * g);
    int res, qb; if (g == 0) { res = 0; qb = i; } else if (g == 1) { res = i >> 2; qb = i & 3; } else { res = i; qb = 0; }
    const size_t row0 = (size_t)bl * SEQ + res, rowq = row0 + (size_t)qb * 256 * d;
    swa::BlockRef r;
    r.q = (unsigned)(WS_QA + (rowq * 1536 + (g * 4 + h) * 128) * 2); r.k = (unsigned)(WS_KA + (row0 * 512 + h * 128) * 2);
    r.o = (unsigned)(WS_OG + (((size_t)g * TH + rowq) * 512 + h * 128) * 2); r.l = (unsigned)(WS_LSE + (((size_t)g * TH + rowq) * 4 + h) * 4);
    r.P0 = qb * 256; r.qp = 1536 * d; r.kp = 512 * d; r.skv = SEQ / d;
    return r;
}
constexpr int ATT_UNITS = 4 * 4 * 48;
__device__ __forceinline__ void p3_attention(Frame& F, char* lds, int bid) {
    int L = bid; if (L >= ATT_UNITS) return;
    swa::BlockRef cur = att_ref(L); swa::Seam S;
    swa::swa_prime(F.ws, cur, lds, S, F.tid);
    for (;;) { const bool more = L + F.G < ATT_UNITS; const int Ln = more ? L + F.G : L;
        const swa::BlockRef nxt = more ? att_ref(Ln) : cur;
        swa::swa_block(F.ws, cur, nxt, lds, S, F.tid);
        if (!more) break;
        cur = nxt; L = Ln; }
}
#ifndef ONE_LAUNCH
#define ONE_LAUNCH 0
#endif
#ifndef ATT_SIMPLE
#define ATT_SIMPLE 1
#endif
#ifndef CHAIN_SIMPLE
#define CHAIN_SIMPLE 1
#endif
constexpr int NPH = 10;
struct Args { const void* in[20]; float* out; unsigned char* ws; RopeTab rt; int ph_lo, ph_hi, h_lo, h_hi, one_launch, pad; };
__global__ void __launch_bounds__(NWAVES * 64, 2) hyb_fwd(Args args) {
    extern __shared__ __attribute__((aligned(16))) unsigned char lds[];
    Frame F;
    F.lds = (LAS unsigned char*)lds;
    F.MISC = (volatile LAS unsigned*)(F.lds + MISC_OFF);
    F.tid = threadIdx.x; F.lane = F.tid & 63; F.wave = __builtin_amdgcn_readfirstlane(F.tid >> 6);
    F.G = gridDim.x; { const int bx = blockIdx.x; F.vcu = (F.G % 8 == 0) ? (bx % 8) * (F.G / 8) + bx / 8 : bx; }
    F.ws = args.ws; F.ctl = (gu32*)(args.ws + WS_CTL);
    F.out = args.out;
#define INF(k) ((const float*)args.in[k])
    for (int u = F.tid; u < (LDS_BYTES - LDSCTL_OFF) / 4; u += NWAVES * 64) ((LAS unsigned*)(F.lds + LDSCTL_OFF))[u] = 0u;
    __syncthreads();
    XcdBarrier bar; bar.bar = (unsigned*)(F.ctl + CW_BAR); bar.x = 0; bar.st = nullptr;
    if (args.one_launch) bar = xcd_barrier_post((unsigned*)(F.ctl + CW_BAR), F.MISC + 8);
#define GRID_BAR() do { if (args.one_launch) xcd_barrier(bar); } while (0)
    const int lo = args.ph_lo, hi = args.ph_hi;
#ifndef PHASE_MASK
#define PHASE_MASK 0x3ff
#endif
#define IN(k) (((PHASE_MASK >> (k)) & 1) && lo <= (k) && (k) < hi)
#define PHASE_BEGIN() do { int w_ = wave0, b_ = bid0; asm volatile("" : "+s"(w_)); asm volatile("" : "+s"(b_)); int t_ = w_ * 64 + (int)__builtin_amdgcn_mbcnt_hi(~0u, __builtin_amdgcn_mbcnt_lo(~0u, 0u)); asm volatile("" : "+v"(t_)); \
        F.tid = t_; F.lane = t_ & 63; F.wave = w_; bid = b_; F.vcu = (F.G % 8 == 0) ? (b_ % 8) * (F.G / 8) + b_ / 8 : b_; } while (0)
    const int wave0 = __builtin_amdgcn_readfirstlane(threadIdx.x >> 6), bid0 = blockIdx.x;
    int bid = blockIdx.x;
    if (IN(0)) { PHASE_BEGIN(); p0a_prologue(F, INF(1), INF(3), INF(4), INF(5), INF(8), INF(9), INF(10), INF(11), INF(15), INF(16), INF(17), (const int*)args.in[2], args.rt.inv2pi, bid); GRID_BAR(); }
    if (IN(1)) { PHASE_BEGIN(); p0b_lnmod(F, INF(0)); GRID_BAR(); }
    for (int half = args.h_lo; half < args.h_hi; ++half) {
        if (IN(2)) { PHASE_BEGIN();
            pg8::Gemm g{1024, 1024, 1024}; pg8::PlainOrder S; S.init(TH / 256, INW / 256, F.G, bid);
            S.set((unsigned char*)F.out + (size_t)half * (64 * MiB), F.ws + WS_WIN, 1024, 1024);
            pg8::EpiProj E{F.ws, (const float*)(F.ws + WS_ROPE) + (size_t)half * TH * 128};
            pg8::gemm_phase<pg8::EpiProj, pg8::PlainOrder, true, true>(F.lds + RING_OFF, g, S, E, F.tid);
            GRID_BAR();
        }
        if (IN(3)) { PHASE_BEGIN(); p2a_conv(F, half, INF(6), INF(7), INF(12), bid); GRID_BAR(); }
        if (IN(4)) { PHASE_BEGIN();
            int kq_ = 256; asm volatile("" : "+s"(kq_)); pg8::Gemm g{1024, 256, kq_}; pg8::QkvOrder S; S.init(TH / 256, 12, F.G, bid);
            S.ws = (const char*)F.ws;
            pg8::EpiQkv E{F.ws};
            pg8::gemm_phase<pg8::EpiQkv, pg8::QkvOrder, true, true>(F.lds + RING_OFF, g, S, E, F.tid);
            GRID_BAR();
        }
        if (IN(5)) { PHASE_BEGIN();
#if CHAIN_SIMPLE
            p3_chain_simple(F, half, bid);
#else
            for (int ch = bid; ch < 128; ch += F.G) chain::run_chain(F.ws, F.lds + RING_OFF, ch, half, F.tid);
#endif
#if ATT_SIMPLE
            p3_attention_simple(F, half);
#else
            __syncthreads(); PHASE_BEGIN();
            p3_attention(F, (char*)lds, bid);
#endif
            GRID_BAR();
        }
        if (IN(6)) { PHASE_BEGIN(); p4a_finalize<!ATT_SIMPLE>(F, half, INF(13), INF(14)); GRID_BAR(); }
        if (IN(7)) { PHASE_BEGIN();
            bf16* MRG = (bf16*)(F.ws + WS_MRG);
            { pg8::Gemm g{512, 512, 512}; pg8::PlainOrder S; S.init(TH / 256, 4, F.G, bid); S.set(F.ws + (ATT_SIMPLE ? WS_OG : WS_ATG), F.ws + WS_WPA, 512, 512);
              pg8::EpiGate<0> E{(const bf16*)(F.ws + WS_GA), MRG}; pg8::gemm_phase<pg8::EpiGate<0>, pg8::PlainOrder, false, true>(F.lds + RING_OFF, g, S, E, F.tid); }
            PHASE_BEGIN();
            { pg8::Gemm g{1024, 1024, 1024}; pg8::PlainOrder S; S.init(TH / 256, 4, F.G, bid); S.set(F.ws + WS_HMG, F.ws + WS_WPM, 1024, 1024);
              pg8::EpiGate<1> E{(const bf16*)(F.ws + WS_GM), MRG}; pg8::gemm_phase<pg8::EpiGate<1>, pg8::PlainOrder, false, true>(F.lds + RING_OFF, g, S, E, F.tid); }
            GRID_BAR();
        }
        if (IN(8)) { PHASE_BEGIN();
            pg8::Gemm g{1024, 1024, 1024}; pg8::PlainOrder S; S.init(TH / 256, 4, F.G, bid); S.set(F.ws + WS_MRG, F.ws + WS_WOUT, 1024, 1024);
            pg8::EpiRes E{INF(0) + (size_t)half * TH * DM, F.out + (size_t)half * TH * DM, (const float*)(F.ws + WS_ADA) + 2048, half * TH, 1.189207115002721f};
            pg8::gemm_phase<pg8::EpiRes, pg8::PlainOrder, false, true>(F.lds + RING_OFF, g, S, E, F.tid);
            GRID_BAR();
        }
        if (IN(9)) { PHASE_BEGIN(); p5b_ln(F, half, INF(18), INF(19)); }
    }
#undef IN
#undef GRID_BAR
}

extern "C" void kernel_launch(void* const* d_in, const int* in_sizes, int n_in, void* d_out, int out_size, void* d_ws, size_t ws_size, hipStream_t stream) {
    static int grid = 0;
    if (grid == 0) {
        if (n_in != 20 || in_sizes[0] != TT * DM || out_size != TT * DM || ws_size < WS_END) { fprintf(stderr, "kernel_launch: unexpected shapes (n_in %d, in0 %d, out %d, ws %zu); nothing launched\n", n_in, n_in > 0 ? in_sizes[0] : -1, out_size, ws_size); grid = -1; return; }
        int dev = 0, cus = 0;
        if (hipGetDevice(&dev) != hipSuccess || hipDeviceGetAttribute(&cus, hipDeviceAttributeMultiprocessorCount, dev) != hipSuccess) { grid = -1; return; }
        if (hipFuncSetAttribute((const void*)hyb_fwd, hipFuncAttributeMaxDynamicSharedMemorySize, LDS_BYTES) != hipSuccess) { fprintf(stderr, "kernel_launch: hipFuncSetAttribute failed\n"); grid = -1; return; }
        int per_cu = 0;
        if (hipOccupancyMaxActiveBlocksPerMultiprocessor(&per_cu, (const void*)hyb_fwd, NWAVES * 64, LDS_BYTES) != hipSuccess || per_cu < 1) fprintf(stderr, "kernel_launch: occupancy query says %d\n", per_cu);
        (void)hipGetLastError();
        grid = cus;
    }
    if (grid < 0) return;
    if (hipMemsetAsync((char*)d_ws + WS_CTL, 0, CTL_ZERO_BYTES, stream) != hipSuccess) return;
    Args a; memset(&a, 0, sizeof(a));
    for (int i = 0; i < 20; ++i) a.in[i] = d_in[i];
    a.out = (float*)d_out; a.ws = (unsigned char*)d_ws;
    for (int e = 0; e < 64; ++e) a.rt.inv2pi[e] = pow(10000.0, -(double)e / 64.0) / 6.283185307179586476925286766559;
#if ONE_LAUNCH
    a.ph_lo = 0; a.ph_hi = NPH; a.h_lo = 0; a.h_hi = NHALF; a.one_launch = 1;
    hipLaunchKernelGGL(hyb_fwd, dim3(grid), dim3(NWAVES * 64), LDS_BYTES, stream, a);
#else
    a.one_launch = 0;
    for (int p = 0; p < 2; ++p) { a.ph_lo = p; a.ph_hi = p + 1; a.h_lo = 0; a.h_hi = 0; hipLaunchKernelGGL(hyb_fwd, dim3(grid), dim3(NWAVES * 64), LDS_BYTES, stream, a); }
    for (int h = 0; h < NHALF; ++h)
        for (int p = 2; p < NPH; ++p) { a.ph_lo = p; a.ph_hi = p + 1; a.h_lo = h; a.h_hi = h + 1; hipLaunchKernelGGL(hyb_fwd, dim3(grid), dim3(NWAVES * 64), LDS_BYTES, stream, a); }
#endif
    const hipError_t le = hipPeekAtLastError();
    if (le != hipSuccess) fprintf(stderr, "kernel_launch: launch failed: %s\n", hipGetErrorName(le));
}
```
